# Optimizing an MI355X kernel written in HIP

```python
import jax, jax.numpy as jnp
from jax import lax
import numpy as np

D_MODEL = 1024
BATCH = 8
SEQ = 4096
DEPTH = 4

MEM_LEN = 256
HEAD_DIM = 64
EPS = 1e-6
GM_WIDTH = D_MODEL // 4
GM_GROUPS = GM_WIDTH // HEAD_DIM
CHUNK = 128
POOL_WIDTH = D_MODEL // 4
POOL_WINDOWS = (2, 4, 8, 16)
POOL_GROUPS = len(POOL_WINDOWS)
POOL_GROUP_DIM = POOL_WIDTH // POOL_GROUPS
ATT_WIDTH = D_MODEL // 2
ATT_Q_HEADS = ATT_WIDTH // HEAD_DIM
ATT_KV_HEADS = ATT_Q_HEADS // 4
ATT_GROUP = ATT_Q_HEADS // ATT_KV_HEADS
WINDOW = 128
ROPE_THETA = 10000.0
D_MIX = GM_WIDTH + POOL_WIDTH + ATT_WIDTH
IN_SIZES = (2 * GM_WIDTH, POOL_WIDTH, ATT_Q_HEADS * HEAD_DIM, ATT_KV_HEADS * HEAD_DIM, ATT_KV_HEADS * HEAD_DIM)
IN_SPLITS = tuple(int(s) for s in np.cumsum(IN_SIZES)[:-1])
D_IN = sum(IN_SIZES)
X_HEADS = 4
X_HEAD_DIM = D_MODEL // X_HEADS
D_FF = -(-8 * D_MODEL // (3 * 256)) * 256

kernel_name = "hybrid_gmlp_pool_swa_sink_trunk"


def rms_norm(x, g):
    xf = x.astype(jnp.float32)
    y = xf * lax.rsqrt(jnp.mean(xf * xf, axis=-1, keepdims=True) + EPS)
    return (y * g.astype(jnp.float32)).astype(x.dtype)


def spatial_gating(uv, v_gain, w_s, b_s):
    B, S, _ = uv.shape
    u, v = jnp.split(uv, 2, axis=-1)
    v = v.reshape(B, S // CHUNK, CHUNK, GM_GROUPS, HEAD_DIM)
    v = rms_norm(v, v_gain.reshape(GM_GROUPS, HEAD_DIM))
    causal = jnp.tril(jnp.ones((CHUNK, CHUNK), dtype=bool))
    w = jnp.where(causal[None], w_s, jnp.zeros_like(w_s))
    mixed = jnp.einsum('gts,bcsgd->bctgd', w, v) + b_s.T[None, None, :, :, None]
    return u * mixed.reshape(B, S, GM_WIDTH)


def multiscale_pool(p, pool_w, pool_scale):
    B, S, _ = p.shape
    pf = p.astype(jnp.float32)
    cs = jnp.pad(jnp.cumsum(pf, axis=1), ((0, 0), (1, 0), (0, 0)))
    t = jnp.arange(S)
    outs = []
    for g, w in enumerate(POOL_WINDOWS):
        sl = slice(g * POOL_GROUP_DIM, (g + 1) * POOL_GROUP_DIM)
        hi = cs[:, 1:, sl]
        lo = jnp.pad(cs[:, :S - w + 1, sl], ((0, 0), (w - 1, 0), (0, 0)))
        count = jnp.minimum(t + 1, w).astype(jnp.float32)[None, :, None]
        outs.append((hi - lo) / count - pf[:, :, sl])
    pooled = jnp.stack(outs, axis=2).astype(p.dtype)
    mapped = jnp.einsum('bsgc,gcd->bsgd', pooled, pool_w).reshape(B, S, POOL_WIDTH)
    return mapped * pool_scale


def rope(x, positions):
    half = HEAD_DIM // 2
    inv = ROPE_THETA ** (-jnp.arange(half, dtype=jnp.float32) / half)
    ang = positions.astype(jnp.float32)[..., None] * inv
    cos = jnp.cos(ang)[:, :, None, :]
    sin = jnp.sin(ang)[:, :, None, :]
    xf = x.astype(jnp.float32)
    x1, x2 = xf[..., :half], xf[..., half:]
    return jnp.concatenate([x1 * cos - x2 * sin, x2 * cos + x1 * sin], axis=-1).astype(x.dtype)


def sliding_window_attention(q, k, v, sinks):
    B, S, _, _ = q.shape
    NB = S // WINDOW
    qb = q.reshape(B, NB, WINDOW, ATT_KV_HEADS, ATT_GROUP, HEAD_DIM)

    def band(t_):
        tb = t_.reshape(B, NB, WINDOW, ATT_KV_HEADS, HEAD_DIM)
        prev = jnp.pad(tb[:, :-1], ((0, 0), (1, 0), (0, 0), (0, 0), (0, 0)))
        return jnp.concatenate([prev, tb], axis=2)

    kb, vb = band(k), band(v)
    scores = jnp.einsum('bnqhgd,bnkhd->bnhgqk', qb, kb,
                        preferred_element_type=jnp.float32) * (HEAD_DIM ** -0.5)
    qi = jnp.arange(WINDOW)[:, None] + WINDOW
    ki = jnp.arange(2 * WINDOW)[None, :]
    rel = qi - ki
    valid = (rel >= 0) & (rel < WINDOW)
    valid = valid[None] & ((jnp.arange(NB) > 0)[:, None, None] | (ki >= WINDOW)[None])
    scores = jnp.where(valid[None, :, None, None], scores, -jnp.inf)
    sink = jnp.broadcast_to(
        sinks.astype(jnp.float32).reshape(ATT_KV_HEADS, ATT_GROUP)[None, None, :, :, None, None],
        scores.shape[:-1] + (1,))
    probs = jax.nn.softmax(jnp.concatenate([scores, sink], axis=-1), axis=-1)[..., :-1]
    out = jnp.einsum('bnhgqk,bnkhd->bnqhgd', probs.astype(v.dtype), vb)
    return out.reshape(B, S, ATT_WIDTH)


def cross_attention(h, mem_n, w_xq, w_xkv, w_xo):
    B, S, _ = h.shape
    M = mem_n.shape[1]
    q = (h @ w_xq).reshape(B, S, X_HEADS, X_HEAD_DIM)
    k, v = jnp.split(mem_n @ w_xkv, 2, axis=-1)
    k = k.reshape(B, M, X_HEADS, X_HEAD_DIM)
    v = v.reshape(B, M, X_HEADS, X_HEAD_DIM)
    s = jnp.einsum('bshd,bmhd->bhsm', q, k, preferred_element_type=jnp.float32) * (X_HEAD_DIM ** -0.5)
    p = jax.nn.softmax(s, axis=-1).astype(v.dtype)
    o = jnp.einsum('bhsm,bmhd->bshd', p, v).reshape(B, S, D_MODEL)
    return o @ w_xo


def setup_inputs(seed: int = 0) -> dict:
    key = jax.random.key(seed)
    ks = jax.random.split(key, 32)
    f32 = jnp.float32

    def nrm(k, shape, scale):
        return jax.random.normal(k, shape, f32) * scale

    def gain(k, shape):
        return 1.0 + 0.05 * jax.random.normal(k, shape, f32)

    offsets = jax.random.randint(ks[2], (BATCH, 1), 0, 1024, dtype=jnp.int32)
    positions = offsets + jnp.arange(SEQ, dtype=jnp.int32)[None, :]
    return {
        "x": nrm(ks[0], (BATCH, SEQ, D_MODEL), 1.0),
        "mem": nrm(ks[1], (BATCH, MEM_LEN, D_MODEL), 1.0),
        "positions": positions,
        "mem_norm_g": gain(ks[3], (D_MODEL,)),
        "mix_pre_g": gain(ks[4], (DEPTH, D_MODEL)),
        "mix_post_g": gain(ks[5], (DEPTH, D_MODEL)),
        "w_in": nrm(ks[6], (DEPTH, D_MODEL, D_IN), D_MODEL ** -0.5),
        "gm_v_g": gain(ks[7], (DEPTH, GM_WIDTH)),
        "gm_w_s": nrm(ks[8], (DEPTH, GM_GROUPS, CHUNK, CHUNK), 0.5 * CHUNK ** -0.5),
        "gm_b_s": 1.0 + 0.1 * jax.random.normal(ks[9], (DEPTH, GM_GROUPS, CHUNK), f32),
        "pool_w": nrm(ks[10], (DEPTH, POOL_GROUPS, POOL_GROUP_DIM, POOL_GROUP_DIM), POOL_GROUP_DIM ** -0.5),
        "pool_scale": 1.0 + 0.1 * jax.random.normal(ks[11], (DEPTH, POOL_WIDTH), f32),
        "attn_sinks": nrm(ks[12], (DEPTH, ATT_Q_HEADS), 1.0),
        "w_o": nrm(ks[13], (DEPTH, D_MIX, D_MODEL), D_MIX ** -0.5),
        "x_pre_g": gain(ks[14], (DEPTH, D_MODEL)),
        "x_post_g": gain(ks[15], (DEPTH, D_MODEL)),
        "w_xq": nrm(ks[16], (DEPTH, D_MODEL, D_MODEL), D_MODEL ** -0.5),
        "w_xkv": nrm(ks[17], (DEPTH, D_MODEL, 2 * D_MODEL), D_MODEL ** -0.5),
        "w_xo": nrm(ks[18], (DEPTH, D_MODEL, D_MODEL), D_MODEL ** -0.5),
        "ffn_pre_g": gain(ks[19], (DEPTH, D_MODEL)),
        "ffn_post_g": gain(ks[20], (DEPTH, D_MODEL)),
        "w_gate_up": nrm(ks[21], (DEPTH, D_MODEL, 2 * D_FF), D_MODEL ** -0.5),
        "w_down": nrm(ks[22], (DEPTH, D_FF, D_MODEL), D_FF ** -0.5),
    }


def reference(x, mem, positions, mem_norm_g, mix_pre_g, mix_post_g, w_in, gm_v_g, gm_w_s, gm_b_s,
              pool_w, pool_scale, attn_sinks, w_o, x_pre_g, x_post_g, w_xq, w_xkv, w_xo,
              ffn_pre_g, ffn_post_g, w_gate_up, w_down):
    B, S, _ = x.shape
    mem_n = rms_norm(mem, mem_norm_g)
    for l in range(DEPTH):
        h = rms_norm(x, mix_pre_g[l])
        z = h @ w_in[l]
        z_gm, z_pool, z_q, z_k, z_v = jnp.split(z, IN_SPLITS, axis=-1)
        a = spatial_gating(jax.nn.gelu(z_gm), gm_v_g[l], gm_w_s[l], gm_b_s[l])
        b = multiscale_pool(z_pool, pool_w[l], pool_scale[l])
        q = rope(z_q.reshape(B, S, ATT_Q_HEADS, HEAD_DIM), positions)
        k = rope(z_k.reshape(B, S, ATT_KV_HEADS, HEAD_DIM), positions)
        v = z_v.reshape(B, S, ATT_KV_HEADS, HEAD_DIM)
        c = sliding_window_attention(q, k, v, attn_sinks[l])
        mix = jnp.concatenate([a, b, c], axis=-1) @ w_o[l]
        x = x + rms_norm(mix, mix_post_g[l])
        h = rms_norm(x, x_pre_g[l])
        x = x + rms_norm(cross_attention(h, mem_n, w_xq[l], w_xkv[l], w_xo[l]), x_post_g[l])
        h = rms_norm(x, ffn_pre_g[l])
        gate, up = jnp.split(h @ w_gate_up[l], 2, axis=-1)
        f = (jax.nn.silu(gate) * up) @ w_down[l]
        x = x + rms_norm(f, ffn_post_g[l])
    return x
```

```cpp
#include <hip/hip_runtime.h>
#include <hip/hip_cooperative_groups.h>
#include <cstdio>
#include <cstdint>
namespace cg = cooperative_groups;

#ifndef MK_PER_PHASE
#define MK_PER_PHASE 0
#endif

typedef __attribute__((address_space(3))) unsigned char lds_u8;
constexpr int DM = 1024, NBATCH = 8, SEQ = 4096, DEPTH = 4, MEML = 256, M = NBATCH * SEQ, MMEM = NBATCH * MEML, D_IN = 1536, D_FF = 2816;
constexpr float EPS = 1e-6f, LOG2E = 1.4426950408889634f;
constexpr int NWAVES = 8, NTHREADS = 512;
constexpr int LDS_BYTES = 147456;
constexpr size_t MiB = 1u << 20;
constexpr size_t WS_WIN = 0, WS_WO = 12 * MiB, WS_WXQ = 20 * MiB, WS_WXO = 28 * MiB, WS_WGU = 36 * MiB, WS_WDN = 80 * MiB, WS_WXKV = 102 * MiB;
constexpr size_t WS_WM = 118 * MiB, WS_PWT = WS_WM + 512 * 1024, WS_RS = WS_PWT + 128 * 1024, WS_YSQ = 468 * MiB;
constexpr size_t WS_PAR = WS_RS + 128 * 1024, PAR_VG = 0, PAR_BS = 1024, PAR_PSC = 3072, PAR_SNK = 4096, PAR_GPOST = 4160;
constexpr size_t WS_COS = 120 * MiB, WS_SIN = 124 * MiB, WS_KM = 128 * MiB, WS_VTM = 144 * MiB, WS_MEMN = 160 * MiB, WS_XB = 164 * MiB, WS_Y = 228 * MiB, WS_R = 292 * MiB;
constexpr size_t WS_U = WS_R, WS_VNT = WS_R + 16 * MiB, WS_P = WS_R + 32 * MiB, WS_Q = WS_R + 48 * MiB, WS_K = WS_R + 80 * MiB, WS_VT = WS_R + 88 * MiB, WS_BUFA = WS_R + 96 * MiB, WS_F = WS_R;
constexpr size_t WS_END = WS_YSQ + 2 * MiB;
static_assert(WS_YSQ == WS_R + 176 * MiB && WS_PAR + (PAR_GPOST + DEPTH * 3 * DM) * 4 <= WS_COS, "ws map");
static_assert((size_t)M * D_FF * 2 <= 176 * MiB, "f fits");


namespace pg8 {
#define PG8_LAS __attribute__((address_space(3)))
typedef unsigned short bf16_t;
typedef short bf16x8 __attribute__((ext_vector_type(8)));
typedef float f32x4 __attribute__((ext_vector_type(4)));
typedef unsigned u32x4 __attribute__((ext_vector_type(4)));
constexpr int BM = 256, BK = 64, HALF = 128, HTB = HALF * BK * 2  , STAGE_BYTES = 8 * HTB, NXCD = 8, WGM = 8;

__host__ __device__ __forceinline__ int lds_byte(int r, int c) { const int st = (r >> 4) * 2 + (c >> 5), rr = r & 15, cc = c & 31, ob = rr * 64 + cc * 2; return st * 1024 + (ob ^ (((ob >> 9) & 1) << 5)); }
__host__ __device__ __forceinline__ void stage_rc(int b, int& R, int& C) { const int st = b / 1024, sb = b % 1024, swz = sb ^ (((sb >> 9) & 1) << 5); R = (st >> 1) * 16 + swz / 64; C = (st & 1) * 32 + (swz % 64) / 2; }
__host__ __device__ __forceinline__ int perm32(int rho) { const int n = rho >> 4, i = rho & 15; return 8 * (i >> 2) + 4 * n + (i & 3); }

struct Unit { int pm, pn; };
struct Gemm { const bf16_t* A; const bf16_t* Bt; int M, N, K; };

struct StaticOrder {
    int nM, nN, nwg, G, c;
    __host__ __device__ void init(int M, int N, int G_, int c_) { nM = M / BM; nN = N / BM; nwg = nM * nN; G = G_; c = c_; }
    __host__ __device__ bool next(int i, Unit& u) const {
        const long L = (long)i * G + c; if (L >= nwg) return false;
        int wgid = (int)L; { const int q = nwg / NXCD, r = nwg % NXCD, xcd = wgid % NXCD, off = wgid / NXCD; wgid = (xcd < r ? xcd * (q + 1) : r * (q + 1) + (xcd - r) * q) + off; }
        const int nig = WGM * nN, gid = wgid / nig, fm = gid * WGM, gsz = (nM - fm) < WGM ? (nM - fm) : WGM;
        u.pm = fm + ((wgid % nig) % gsz); u.pn = (wgid % nig) / gsz; return true;
    }
    __device__ __forceinline__ void a_ready(const Unit&) const {}
    __device__ __forceinline__ void done(const Unit&) const {}
};


typedef unsigned u32x2 __attribute__((ext_vector_type(2)));
typedef float f32x2 __attribute__((ext_vector_type(2)));
typedef __bf16 bf16v2 __attribute__((ext_vector_type(2)));
__device__ __forceinline__ unsigned pk2(float lo, float hi) { f32x2 v = {lo, hi}; bf16v2 b = __builtin_convertvector(v, bf16v2); return __builtin_bit_cast(unsigned, b); }
__device__ __forceinline__ bf16_t f2bf1(float v) { return (bf16_t)(pk2(v, 0.f) & 0xffffu); }
__device__ __forceinline__ u32x4 pk8(const f32x4 a, const f32x4 b) { u32x4 w; w.x = pk2(a[0], a[1]); w.y = pk2(a[2], a[3]); w.z = pk2(b[0], b[1]); w.w = pk2(b[2], b[3]); return w; }
__device__ __forceinline__ float gelu_tanh(float x) {
    const float u = x * (1.f + 0.044715f * x * x);
    const float e = __builtin_amdgcn_exp2f(u * (-2.f * 0.7978845608028654f * 1.4426950408889634f));
    return x * __builtin_amdgcn_rcpf(1.f + e);
}
__device__ __forceinline__ float silu_f(float x) { return x * __builtin_amdgcn_rcpf(1.f + __builtin_amdgcn_exp2f(x * -1.4426950408889634f)); }
constexpr float NORM_EPS = 1e-6f;
constexpr float QSCALE_SWA = 0.125f * 1.4426950408889634f;
constexpr float QSCALE_X = 0.0625f * 1.4426950408889634f;

struct EpiIn {
    static constexpr bool PERM = true, AFTER_DRAIN = false;
    unsigned char* ws; int l;
    __device__ __forceinline__ void operator()(const f32x4 (&acc)[2][2][4][2], const Unit& u, int wr, int wc, int fr, int fq) const {
        asm volatile("" : "+v"(fr), "+v"(fq), "+s"(wr), "+s"(wc));
        const float* rs = (const float*)(ws + WS_RS); bf16_t* U = (bf16_t*)(ws + WS_U); bf16_t* VNT = (bf16_t*)(ws + WS_VNT); bf16_t* P = (bf16_t*)(ws + WS_P); bf16_t* Q = (bf16_t*)(ws + WS_Q);
        bf16_t* Kb = (bf16_t*)(ws + WS_K); bf16_t* VT = (bf16_t*)(ws + WS_VT); const float* vgain = (const float*)(ws + WS_PAR) + PAR_VG + l * 256;
        const float* cosT = (const float*)(ws + WS_COS); const float* sinT = (const float*)(ws + WS_SIN);
        const int pn = u.pn;
        const int rbase = u.pm * BM + wr * 64 + fr;
        if (pn == 0 || pn == 2) {
            bf16_t* O = (pn == 0) ? U : P;
#pragma unroll
            for (int ai = 0; ai < 2; ++ai)
#pragma unroll
                for (int m = 0; m < 4; ++m) { const int r = rbase + ai * HALF + m * 16; const float s = rs[r];
#pragma unroll
                    for (int bj = 0; bj < 2; ++bj) { f32x4 v0 = acc[ai][bj][m][0] * s, v1 = acc[ai][bj][m][1] * s;
                        if (pn == 0) {
#pragma unroll
                            for (int j = 0; j < 4; ++j) { v0[j] = gelu_tanh(v0[j]); v1[j] = gelu_tanh(v1[j]); } }
                        *(u32x4*)(O + (size_t)r * 256 + bj * HALF + wc * 32 + fq * 8) = pk8(v0, v1); } asm volatile("" ::: "memory"); }
        } else if (pn == 1) {
            const int g = wc;
#pragma unroll
            for (int ai = 0; ai < 2; ++ai)
#pragma unroll
                for (int m = 0; m < 4; ++m) { const int r = rbase + ai * HALF + m * 16; const float s = rs[r];
                    float v[2][2][4]; float ss = 0.f;
#pragma unroll
                    for (int bj = 0; bj < 2; ++bj)
#pragma unroll
                        for (int n = 0; n < 2; ++n)
#pragma unroll
                            for (int j = 0; j < 4; ++j) { const float t = gelu_tanh(acc[ai][bj][m][n][j] * s); v[bj][n][j] = t; ss += t * t; }
                    ss += __shfl_xor(ss, 16); ss += __shfl_xor(ss, 32);
                    const float rn = rsqrtf(ss * (1.f / 64.f) + NORM_EPS);
                    const int chunk = r >> 7, sidx = r & 127;
                    bf16_t* base = VNT + ((size_t)(chunk * 4 + g) * 64) * 128 + sidx;
#pragma unroll
                    for (int bj = 0; bj < 2; ++bj)
#pragma unroll
                        for (int n = 0; n < 2; ++n)
#pragma unroll
                            for (int j = 0; j < 4; ++j) { const int dd = 32 * bj + 8 * fq + 4 * n + j;
                                base[(size_t)dd * 128] = f2bf1(v[bj][n][j] * rn * vgain[g * 64 + dd]); } asm volatile("" ::: "memory"); }
        } else {
            const int ii = 4 * (wc & 1) + fq;
#pragma unroll
            for (int ai = 0; ai < 2; ++ai)
#pragma unroll
                for (int m = 0; m < 4; ++m) { const int r = rbase + ai * HALF + m * 16; const float s = rs[r];
                    const f32x4 c4 = *(const f32x4*)(cosT + (size_t)r * 32 + 4 * ii), s4 = *(const f32x4*)(sinT + (size_t)r * 32 + 4 * ii);
#pragma unroll
                    for (int bj = 0; bj < 2; ++bj) {
                        if (pn == 5 && bj == 1) {
                            const int hv = wc >> 1, b = r >> 12, nblk = (r >> 7) & 31;
                            bf16_t* base = VT + ((size_t)((b * 2 + hv) * 32 + nblk) * 64 + 32 * (wc & 1) + 8 * fq) * 128 + (r & 127);
#pragma unroll
                            for (int n = 0; n < 2; ++n)
#pragma unroll
                                for (int j = 0; j < 4; ++j) base[(4 * n + j) * 128] = f2bf1(acc[ai][bj][m][n][j] * s);
                        } else {
                            const float sc = (pn == 5) ? s : s * QSCALE_SWA;
                            const f32x4 x1 = acc[ai][bj][m][0] * sc, x2 = acc[ai][bj][m][1] * sc;
                            const f32x4 o1 = x1 * c4 - x2 * s4, o2 = x2 * c4 + x1 * s4;
                            bf16_t* dst = (pn == 5) ? (Kb + (size_t)r * 128 + wc * 32 + fq * 8) : (Q + (size_t)r * 512 + (pn - 3) * 256 + bj * HALF + wc * 32 + fq * 8);
                            *(u32x4*)dst = pk8(o1, o2);
                        } } asm volatile("" ::: "memory"); }
        }
    }
};

struct EpiY {
    static constexpr bool PERM = true, AFTER_DRAIN = false;
    unsigned char* ws;
    __device__ __forceinline__ void operator()(const f32x4 (&acc)[2][2][4][2], const Unit& u, int wr, int wc, int fr, int fq) const {
        asm volatile("" : "+v"(fr), "+v"(fq), "+s"(wr), "+s"(wc));
        bf16_t* Y = (bf16_t*)(ws + WS_Y); float* ysq = (float*)(ws + WS_YSQ);
        const int rbase = u.pm * BM + wr * 64 + fr, cbase = u.pn * BM + wc * 32 + fq * 8;
#pragma unroll
        for (int ai = 0; ai < 2; ++ai)
#pragma unroll
            for (int m = 0; m < 4; ++m) { const int r = rbase + ai * HALF + m * 16; float ss = 0.f;
#pragma unroll
                for (int bj = 0; bj < 2; ++bj) { const f32x4 v0 = acc[ai][bj][m][0], v1 = acc[ai][bj][m][1];
                    ss += (v0[0] * v0[0] + v0[1] * v0[1]) + (v0[2] * v0[2] + v0[3] * v0[3]) + (v1[0] * v1[0] + v1[1] * v1[1]) + (v1[2] * v1[2] + v1[3] * v1[3]);
                    *(u32x4*)(Y + (size_t)r * 1024 + cbase + bj * HALF) = pk8(v0, v1); }
                ss += __shfl_xor(ss, 16); ss += __shfl_xor(ss, 32);
                if (fq == 0) ysq[(size_t)r * 16 + u.pn * 4 + wc] = ss; asm volatile("" ::: "memory"); }
    }
};

struct EpiQx {
    static constexpr bool PERM = true, AFTER_DRAIN = false;
    unsigned char* ws;
    __device__ __forceinline__ void operator()(const f32x4 (&acc)[2][2][4][2], const Unit& u, int wr, int wc, int fr, int fq) const {
        asm volatile("" : "+v"(fr), "+v"(fq), "+s"(wr), "+s"(wc));
        const float* rs = (const float*)(ws + WS_RS); bf16_t* O = (bf16_t*)(ws + WS_BUFA);
        const int rbase = u.pm * BM + wr * 64 + fr, cbase = u.pn * BM + wc * 32 + fq * 8;
#pragma unroll
        for (int ai = 0; ai < 2; ++ai)
#pragma unroll
            for (int m = 0; m < 4; ++m) { const int r = rbase + ai * HALF + m * 16; const float s = rs[r] * QSCALE_X;
#pragma unroll
                for (int bj = 0; bj < 2; ++bj) *(u32x4*)(O + (size_t)r * 1024 + cbase + bj * HALF) = pk8(acc[ai][bj][m][0] * s, acc[ai][bj][m][1] * s); }
    }
};

struct EpiKV {
    static constexpr bool PERM = true, AFTER_DRAIN = false;
    unsigned char* ws;
    __device__ __forceinline__ void operator()(const f32x4 (&acc)[2][2][4][2], const Unit& u, int wr, int wc, int fr, int fq) const {
        asm volatile("" : "+v"(fr), "+v"(fq), "+s"(wr), "+s"(wc));
        bf16_t* KM = (bf16_t*)(ws + WS_KM); bf16_t* VTM = (bf16_t*)(ws + WS_VTM);
        const int layer = u.pn >> 3, t = u.pn & 7;
        const int rbase = u.pm * BM + wr * 64 + fr;
#pragma unroll
        for (int ai = 0; ai < 2; ++ai)
#pragma unroll
            for (int m = 0; m < 4; ++m) { const int r = rbase + ai * HALF + m * 16;
#pragma unroll
                for (int bj = 0; bj < 2; ++bj) {
                    if (t < 4) *(u32x4*)(KM + ((size_t)layer * 2048 + r) * 1024 + t * 256 + bj * HALF + wc * 32 + fq * 8) = pk8(acc[ai][bj][m][0], acc[ai][bj][m][1]);
                    else { const int b = r >> 8, mm = r & 255, head = t - 4;
                        bf16_t* base = VTM + ((size_t)((layer * 8 + b) * 4 + head) * 256) * 256 + mm;
#pragma unroll
                        for (int n = 0; n < 2; ++n)
#pragma unroll
                            for (int j = 0; j < 4; ++j) { const int d = bj * HALF + wc * 32 + fq * 8 + 4 * n + j; base[(size_t)d * 256] = f2bf1(acc[ai][bj][m][n][j]); } } } }
    }
};

struct EpiGU {
    static constexpr bool PERM = true, AFTER_DRAIN = false;
    unsigned char* ws;
    __device__ __forceinline__ void operator()(const f32x4 (&acc)[2][2][4][2], const Unit& u, int wr, int wc, int fr, int fq) const {
        asm volatile("" : "+v"(fr), "+v"(fq), "+s"(wr), "+s"(wc));
        const float* rs = (const float*)(ws + WS_RS); bf16_t* F = (bf16_t*)(ws + WS_F);
        const int rbase = u.pm * BM + wr * 64 + fr, cbase = u.pn * 128 + wc * 16 + fq * 4;
#pragma unroll
        for (int ai = 0; ai < 2; ++ai)
#pragma unroll
            for (int m = 0; m < 4; ++m) { const int r = rbase + ai * HALF + m * 16; const float s = rs[r];
#pragma unroll
                for (int bj = 0; bj < 2; ++bj) { const f32x4 g = acc[ai][bj][m][0] * s, up = acc[ai][bj][m][1] * s;
                    u32x2 w; w.x = pk2(silu_f(g[0]) * up[0], silu_f(g[1]) * up[1]); w.y = pk2(silu_f(g[2]) * up[2], silu_f(g[3]) * up[3]);
                    *(u32x2*)(F + (size_t)r * 2816 + cbase + bj * 64) = w; } }
    }
};

template <class Epi, class Sched, bool ALIGN_EPI = false, bool SP2 = false>
__device__ __forceinline__ void gemm_phase(PG8_LAS unsigned char* lds, const Gemm g, const Sched& S, const Epi& E) {
    int tid_ = threadIdx.x; asm volatile("" : "+v"(tid_));
    const int tid = tid_, wid = __builtin_amdgcn_readfirstlane(tid >> 6), lane = tid & 63, wr = wid >> 2, wc = wid & 3, fr = lane & 15, fq = lane >> 4;
    const int K = g.K, nt = K / BK;
    unsigned voffA[2], voffB[2];
#pragma unroll
    for (int i = 0; i < 2; ++i) { int R, C; stage_rc(tid * 16 + i * 8192, R, C); const int Rb = Epi::PERM ? ((R & ~31) + perm32(R & 31)) : R;
        voffA[i] = (unsigned)(R * K + C) * 2u; voffB[i] = (unsigned)(Rb * K + C) * 2u; }
    const size_t kstep = (size_t)(BK * 2);
    const size_t hstep = (size_t)HALF * K * 2;
    const size_t tstep = 2 * hstep;
    const unsigned ldsw = (unsigned)wid * 1024u;
    const int aoff = lds_byte(wr * 64 + fr, fq * 8), boff = lds_byte(wc * 32 + fr, fq * 8);
#define PG8_SA(b, h) (((b) * 2 + (h)) * HTB)
#define PG8_SB(b, h) ((4 + (b) * 2 + (h)) * HTB)
#define PG8_STAGE(bufoff, gbase, voff) do { _Pragma("unroll") for (int _i = 0; _i < 2; ++_i) \
        __builtin_amdgcn_global_load_lds((const unsigned*)((const char*)(gbase) + (voff)[_i]), (PG8_LAS unsigned*)(lds + (bufoff) + ldsw + _i * 8192), 16, 0, 0); } while (0)
#define PG8_LDA(dst, b, h) do { _Pragma("unroll") for (int m = 0; m < 4; ++m) _Pragma("unroll") for (int k = 0; k < 2; ++k) dst[m][k] = *(const PG8_LAS bf16x8*)(lds + PG8_SA(b, h) + aoff + m * 2048 + k * 1024); } while (0)
#define PG8_LDB(dst, b, h) do { _Pragma("unroll") for (int n = 0; n < 2; ++n) _Pragma("unroll") for (int k = 0; k < 2; ++k) dst[n][k] = *(const PG8_LAS bf16x8*)(lds + PG8_SB(b, h) + boff + n * 2048 + k * 1024); } while (0)
#define PG8_MMA(ai, bj, At, Bt) do { __builtin_amdgcn_s_setprio(1); _Pragma("unroll") for (int m = 0; m < 4; ++m) _Pragma("unroll") for (int n = 0; n < 2; ++n) _Pragma("unroll") for (int k = 0; k < 2; ++k) \
        acc[ai][bj][m][n] = __builtin_amdgcn_mfma_f32_16x16x32_bf16(Bt[n][k], At[m][k], acc[ai][bj][m][n], 0, 0, 0); __builtin_amdgcn_s_setprio(0); } while (0)
#define PG8_WAIT_V(n) asm volatile("s_waitcnt vmcnt(" #n ")" ::: "memory")
#define PG8_WAIT_L(n) asm volatile("s_waitcnt lgkmcnt(" #n ")" ::: "memory")
#define PG8_BAR __builtin_amdgcn_s_barrier()
#define PG8_SCHED __builtin_amdgcn_sched_barrier(0)
    Unit cur, nxt; int ui = 0;
    if (!S.next(0, cur)) return;
    f32x4 acc[2][2][4][2];
#pragma unroll
    for (int a = 0; a < 2; ++a)
#pragma unroll
        for (int b = 0; b < 2; ++b)
#pragma unroll
            for (int m = 0; m < 4; ++m)
#pragma unroll
                for (int n = 0; n < 2; ++n) acc[a][b][m][n] = (f32x4){0.f, 0.f, 0.f, 0.f};
    bf16x8 At[4][2], B0[2][2], B1[2][2];
    const char* cA = (const char*)g.A + (size_t)cur.pm * tstep; const char* cB = (const char*)g.Bt + (size_t)cur.pn * tstep;
    S.a_ready(cur);
    if constexpr (SP2) {
        PG8_STAGE(PG8_SB(0, 0), cB, voffB); PG8_STAGE(PG8_SB(0, 1), cB + hstep, voffB); PG8_STAGE(PG8_SA(0, 0), cA, voffA); PG8_STAGE(PG8_SA(0, 1), cA + hstep, voffA);
        if (wr == 1) PG8_BAR;
        PG8_WAIT_V(2); PG8_BAR;
        PG8_STAGE(PG8_SB(1, 0), cB + kstep, voffB); PG8_STAGE(PG8_SA(1, 0), cA + kstep, voffA); PG8_STAGE(PG8_SB(1, 1), cB + hstep + kstep, voffB);
        PG8_WAIT_V(6); PG8_BAR;
    } else {
        PG8_STAGE(PG8_SB(0, 0), cB, voffB); PG8_STAGE(PG8_SA(0, 0), cA, voffA); PG8_STAGE(PG8_SB(0, 1), cB + hstep, voffB); PG8_STAGE(PG8_SA(0, 1), cA + hstep, voffA);
        if (wr == 1) PG8_BAR;
        PG8_WAIT_V(4); PG8_BAR;
        PG8_STAGE(PG8_SB(1, 0), cB + kstep, voffB); PG8_STAGE(PG8_SA(1, 0), cA + kstep, voffA); PG8_STAGE(PG8_SB(1, 1), cB + hstep + kstep, voffB);
        PG8_WAIT_V(6); PG8_BAR;
    }
    for (;;) {
        const bool has_next = S.next(ui + 1, nxt);
        const char* nA = has_next ? (const char*)g.A + (size_t)nxt.pm * tstep : cA; const char* nB = has_next ? (const char*)g.Bt + (size_t)nxt.pn * tstep : cB;
        for (int t = 0; t < nt; t += 2) {
            const bool last = (t == nt - 2);
            const char* a1 = cA + (size_t)(t + 1) * kstep;
            const char* a2 = last ? nA : cA + (size_t)(t + 2) * kstep; const char* b2 = last ? nB : cB + (size_t)(t + 2) * kstep;
            const char* a3 = a2 + kstep; const char* b3 = b2 + kstep;
            if (last && has_next) S.a_ready(nxt);
            if constexpr (SP2) {
            PG8_LDB(B0, 0, 0); PG8_LDB(B1, 0, 1); PG8_SCHED; PG8_LDA(At, 0, 0); PG8_STAGE(PG8_SA(1, 1), a1 + hstep, voffA);
            PG8_WAIT_V(8); PG8_WAIT_L(0); PG8_BAR; PG8_MMA(0, 0, At, B0); PG8_MMA(0, 1, At, B1); PG8_BAR; PG8_SCHED;
            PG8_LDA(At, 0, 1); PG8_STAGE(PG8_SB(0, 0), b2, voffB); PG8_STAGE(PG8_SB(0, 1), b2 + hstep, voffB); PG8_STAGE(PG8_SA(0, 0), a2, voffA);
            PG8_WAIT_V(8); PG8_WAIT_L(0); PG8_BAR; PG8_MMA(1, 0, At, B0); PG8_MMA(1, 1, At, B1); PG8_BAR; PG8_SCHED;
            PG8_LDB(B0, 1, 0); PG8_LDB(B1, 1, 1); PG8_SCHED; PG8_LDA(At, 1, 0); PG8_STAGE(PG8_SA(0, 1), a2 + hstep, voffA);
            PG8_WAIT_V(8); PG8_WAIT_L(0); PG8_BAR; PG8_MMA(0, 0, At, B0); PG8_MMA(0, 1, At, B1); PG8_BAR; PG8_SCHED;
            PG8_LDA(At, 1, 1); PG8_STAGE(PG8_SB(1, 0), b3, voffB); PG8_STAGE(PG8_SB(1, 1), b3 + hstep, voffB); PG8_STAGE(PG8_SA(1, 0), a3, voffA);
            PG8_WAIT_V(8); PG8_WAIT_L(0); PG8_BAR; PG8_MMA(1, 0, At, B0); PG8_MMA(1, 1, At, B1); PG8_BAR; PG8_SCHED;
            } else {
            PG8_LDB(B0, 0, 0); PG8_SCHED; PG8_LDA(At, 0, 0); PG8_STAGE(PG8_SA(1, 1), a1 + hstep, voffA);
            PG8_WAIT_L(8); PG8_BAR; PG8_WAIT_L(0); PG8_MMA(0, 0, At, B0); PG8_BAR; PG8_SCHED;
            PG8_LDB(B1, 0, 1); PG8_STAGE(PG8_SB(0, 0), b2, voffB);
            PG8_BAR; PG8_WAIT_L(0); PG8_MMA(0, 1, At, B1); PG8_BAR;
            PG8_LDA(At, 0, 1); PG8_STAGE(PG8_SA(0, 0), a2, voffA);
            PG8_BAR; PG8_WAIT_L(0); PG8_MMA(1, 0, At, B0); PG8_BAR; PG8_SCHED;
            PG8_STAGE(PG8_SB(0, 1), b2 + hstep, voffB);
            PG8_WAIT_V(6); PG8_BAR; PG8_MMA(1, 1, At, B1); PG8_BAR;
            PG8_LDB(B0, 1, 0); PG8_SCHED; PG8_LDA(At, 1, 0); PG8_STAGE(PG8_SA(0, 1), a2 + hstep, voffA);
            PG8_WAIT_L(8); PG8_BAR; PG8_WAIT_L(0); PG8_MMA(0, 0, At, B0); PG8_BAR; PG8_SCHED;
            PG8_LDB(B1, 1, 1); PG8_STAGE(PG8_SB(1, 0), b3, voffB);
            PG8_BAR; PG8_WAIT_L(0); PG8_MMA(0, 1, At, B1); PG8_BAR;
            PG8_LDA(At, 1, 1); PG8_STAGE(PG8_SA(1, 0), a3, voffA);
            PG8_BAR; PG8_WAIT_L(0); PG8_MMA(1, 0, At, B0); PG8_BAR; PG8_SCHED;
            PG8_STAGE(PG8_SB(1, 1), b3 + hstep, voffB);
            PG8_WAIT_V(6); PG8_BAR; PG8_MMA(1, 1, At, B1); PG8_BAR;
            }
        }
        if constexpr (ALIGN_EPI) { if (wr == 0) PG8_BAR; }
        if constexpr (!Epi::AFTER_DRAIN) { E(acc, cur, wr, wc, fr, fq); S.done(cur); }
        if (!has_next) break;
#pragma unroll
        for (int a = 0; a < 2; ++a)
#pragma unroll
            for (int b = 0; b < 2; ++b)
#pragma unroll
                for (int m = 0; m < 4; ++m)
#pragma unroll
                    for (int n = 0; n < 2; ++n) acc[a][b][m][n] = (f32x4){0.f, 0.f, 0.f, 0.f};
        cur = nxt; cA = nA; cB = nB; ++ui;
        if constexpr (ALIGN_EPI) { if (wr == 1) PG8_BAR; }
    }
    PG8_WAIT_V(0);
    if constexpr (!ALIGN_EPI) { if (wr == 0) PG8_BAR; }
    PG8_BAR;
    if constexpr (Epi::AFTER_DRAIN) { E.fused(acc, cur, wr, wc, fr, fq, lds, wid, lane); S.done(cur); }
#undef PG8_SA
#undef PG8_SB
#undef PG8_STAGE
#undef PG8_LDA
#undef PG8_LDB
#undef PG8_MMA
#undef PG8_WAIT_V
#undef PG8_WAIT_L
#undef PG8_BAR
#undef PG8_SCHED
}
}

#define LAS __attribute__((address_space(3)))
#define DI __device__ __forceinline__
typedef unsigned short bf16;
typedef short bf16x8 __attribute__((ext_vector_type(8)));
typedef short s16x4 __attribute__((ext_vector_type(4)));
typedef float f32x4 __attribute__((ext_vector_type(4)));
typedef float f32x16 __attribute__((ext_vector_type(16)));
typedef unsigned u32x4 __attribute__((ext_vector_type(4)));
typedef unsigned u32x2 __attribute__((ext_vector_type(2)));
#define MFMA32(a, b, c) __builtin_amdgcn_mfma_f32_32x32x16_bf16((a), (b), (c), 0, 0, 0)
using pg8::pk2; using pg8::f2bf1;
DI float bf2f(unsigned v) { return __uint_as_float(v << 16); }
DI int crow(int i, int h) { return (i & 3) + 8 * (i >> 2) + 4 * h; }

__device__ const float INV_FREQ[32] = {1.000000000e+00f, 7.498942614e-01f, 5.623413324e-01f, 4.216965139e-01f, 3.162277639e-01f, 2.371373773e-01f, 1.778279394e-01f, 1.333521307e-01f,
    1.000000015e-01f, 7.498941571e-02f, 5.623413250e-02f, 4.216965288e-02f, 3.162277490e-02f, 2.371373773e-02f, 1.778279431e-02f, 1.333521493e-02f,
    9.999999776e-03f, 7.498941850e-03f, 5.623413250e-03f, 4.216964822e-03f, 3.162277630e-03f, 2.371373586e-03f, 1.778279431e-03f, 1.333521446e-03f,
    1.000000047e-03f, 7.498942432e-04f, 5.623413017e-04f, 4.216965172e-04f, 3.162277571e-04f, 2.371373703e-04f, 1.778279402e-04f, 1.333521504e-04f};

struct Args { const void* in[23]; float* out; unsigned char* ws; int ph_lo, ph_hi; };

DI int opaque_tid() { int t = threadIdx.x; asm volatile("" : "+v"(t)); return t; }
DI int opaque_bid() { int b = blockIdx.x; asm volatile("" : "+s"(b)); return b; }
DI float wave_sum(float v) {
#pragma unroll
    for (int o = 1; o < 64; o <<= 1) v += __shfl_xor(v, o);
    return v;
}

DI int rowmap(int mode, int n) {
    if (mode == 1) {
        if (n < 256) return n;
        if (n < 512) { const int q = n - 256, g = q >> 6, dd = q & 63; return 256 + 128 * (dd >> 5) + 32 * g + (dd & 31); }
        if (n < 768) return n;
        if (n < 1408) { const int base = n & ~63, d = n & 63; return base + 8 * ((d & 31) >> 2) + 4 * (d >> 5) + (d & 3); }
        return n;
    }
    if (mode == 2) {
        if (n < D_FF) return 8 * (n >> 2) + (n & 3);
        const int q = n - D_FF; return 8 * (q >> 2) + 4 + (q & 3);
    }
    return n;
}
DI void transpose_item(const float* W, int K, int N, bf16* WT, int mode, const float* gain, LAS float* scr, int item, int lane) {
    const int nblk = N / 32, kb = item / nblk, nbk = item % nblk, k0 = 64 * kb, n0 = 32 * nbk;
#pragma unroll 8
    for (int i = 0; i < 32; ++i) { const int kk = 2 * i + (lane >> 5); float v = W[(size_t)(k0 + kk) * N + n0 + (lane & 31)]; if (gain) v *= gain[k0 + kk]; scr[kk * 33 + (lane & 31)] = v; }
    asm volatile("s_waitcnt lgkmcnt(0)" ::: "memory"); __builtin_amdgcn_wave_barrier();
    const int c = lane & 7;
#pragma unroll
    for (int j = 0; j < 4; ++j) { const int n = (lane >> 3) + 8 * j; const LAS float* s = scr + (8 * c) * 33 + n;
        u32x4 o; o.x = pk2(s[0 * 33], s[1 * 33]); o.y = pk2(s[2 * 33], s[3 * 33]); o.z = pk2(s[4 * 33], s[5 * 33]); o.w = pk2(s[6 * 33], s[7 * 33]);
        *(u32x4*)(WT + (size_t)rowmap(mode, n0 + n) * K + k0 + 8 * c) = o; }
    asm volatile("s_waitcnt lgkmcnt(0)" ::: "memory"); __builtin_amdgcn_wave_barrier();
}

DI void prologue(const Args& a, LAS unsigned char* lds, int G) {
    unsigned char* ws = a.ws;
    const int tid = threadIdx.x, lane = tid & 63, wave = tid >> 6;
    const int gw = blockIdx.x * NWAVES + wave, NGW = G * NWAVES;
    const int gt = blockIdx.x * NTHREADS + tid, NGT = G * NTHREADS;
    LAS float* scr = (LAS float*)(lds + wave * 16384);
    constexpr int I_IN = 16 * 48, I_O = 16 * 32, I_GU = 16 * 176, I_DN = 44 * 32, I_KV = 16 * 64;
    constexpr int PER_L = I_IN + 3 * I_O + I_GU + I_DN + I_KV;
    for (int it = gw; it < DEPTH * PER_L; it += NGW) {
        const int l = it / PER_L; int r = it % PER_L;
        if (r < I_IN) { transpose_item(((const float*)a.in[6]) + (size_t)l * DM * D_IN, DM, D_IN, (bf16*)(ws + WS_WIN) + (size_t)l * D_IN * DM, 1, ((const float*)a.in[4]) + l * DM, scr, r, lane); continue; } r -= I_IN;
        if (r < I_O) { transpose_item(((const float*)a.in[13]) + (size_t)l * DM * DM, DM, DM, (bf16*)(ws + WS_WO) + (size_t)l * DM * DM, 0, nullptr, scr, r, lane); continue; } r -= I_O;
        if (r < I_O) { transpose_item(((const float*)a.in[16]) + (size_t)l * DM * DM, DM, DM, (bf16*)(ws + WS_WXQ) + (size_t)l * DM * DM, 0, ((const float*)a.in[14]) + l * DM, scr, r, lane); continue; } r -= I_O;
        if (r < I_O) { transpose_item(((const float*)a.in[18]) + (size_t)l * DM * DM, DM, DM, (bf16*)(ws + WS_WXO) + (size_t)l * DM * DM, 0, nullptr, scr, r, lane); continue; } r -= I_O;
        if (r < I_GU) { transpose_item(((const float*)a.in[21]) + (size_t)l * DM * 2 * D_FF, DM, 2 * D_FF, (bf16*)(ws + WS_WGU) + (size_t)l * 2 * D_FF * DM, 2, ((const float*)a.in[19]) + l * DM, scr, r, lane); continue; } r -= I_GU;
        if (r < I_DN) { transpose_item(((const float*)a.in[22]) + (size_t)l * D_FF * DM, D_FF, DM, (bf16*)(ws + WS_WDN) + (size_t)l * DM * D_FF, 0, nullptr, scr, r, lane); continue; } r -= I_DN;
        transpose_item(((const float*)a.in[17]) + (size_t)l * DM * 2 * DM, DM, 2 * DM, (bf16*)(ws + WS_WXKV) + (size_t)l * 2 * DM * DM, 0, nullptr, scr, r, lane);
    }
    { bf16* WMk = (bf16*)(ws + WS_WM);
      for (int i = gt; i < DEPTH * 4 * 128 * 128; i += NGT) { const int s = i & 127, t = (i >> 7) & 127; WMk[i] = (s <= t) ? f2bf1(((const float*)a.in[8])[i]) : (bf16)0; }
      bf16* PWT = (bf16*)(ws + WS_PWT);
      for (int i = gt; i < DEPTH * 4 * 64 * 64; i += NGT) { const int c = i & 63, d = (i >> 6) & 63, lg = i >> 12; PWT[i] = f2bf1(((const float*)a.in[10])[(size_t)lg * 4096 + c * 64 + d]); }
      float* par = (float*)(ws + WS_PAR);
      for (int i = gt; i < 1024; i += NGT) par[PAR_VG + i] = ((const float*)a.in[7])[i];
      for (int i = gt; i < 2048; i += NGT) par[PAR_BS + i] = ((const float*)a.in[9])[i];
      for (int i = gt; i < 1024; i += NGT) par[PAR_PSC + i] = ((const float*)a.in[11])[i];
      for (int i = gt; i < 32; i += NGT) par[PAR_SNK + i] = ((const float*)a.in[12])[i];
      for (int i = gt; i < DEPTH * 3 * DM; i += NGT) { const int l = i / (3 * DM), k = (i / DM) % 3, c = i % DM; par[PAR_GPOST + i] = ((const float*)a.in[k == 0 ? 5 : (k == 1 ? 15 : 20)])[l * DM + c]; }
      float* cosT = (float*)(ws + WS_COS); float* sinT = (float*)(ws + WS_SIN);
      for (int i = gt; i < M * 32; i += NGT) {
          const int r = i >> 5, k = i & 31;
          const float ang = (float)((const int*)a.in[2])[r] * INV_FREQ[k];
          const double ad = (double)ang;
          const double q = __builtin_rint(ad * 0.63661977236758134308);
          double rr = __builtin_fma(-q, 1.57079632679489655800e+00, ad); rr = __builtin_fma(-q, 6.12323399573676603587e-17, rr);
          const double x2 = rr * rr;
          double sp = -1.0 / 6227020800.0; sp = sp * x2 + 1.0 / 39916800.0; sp = sp * x2 - 1.0 / 362880.0; sp = sp * x2 + 1.0 / 5040.0; sp = sp * x2 - 1.0 / 120.0; sp = sp * x2 + 1.0 / 6.0; sp = rr - rr * x2 * sp;
          double cp = 1.0 / 87178291200.0; cp = cp * x2 - 1.0 / 479001600.0; cp = cp * x2 + 1.0 / 3628800.0; cp = cp * x2 - 1.0 / 40320.0; cp = cp * x2 + 1.0 / 720.0; cp = cp * x2 - 1.0 / 24.0; cp = cp * x2 + 0.5; cp = 1.0 - x2 * cp;
          const int qi = ((int)q) & 3;
          const double sv = (qi == 0) ? sp : (qi == 1) ? cp : (qi == 2) ? -sp : -cp;
          const double cv = (qi == 0) ? cp : (qi == 1) ? -sp : (qi == 2) ? -cp : sp;
          cosT[i] = (float)cv; sinT[i] = (float)sv;
      }
    }
    { bf16* XB = (bf16*)(ws + WS_XB); float* rsx = (float*)(ws + WS_RS);
      for (int r = gw; r < M; r += NGW) {
          const f32x4* xr = (const f32x4*)(((const float*)a.in[0]) + (size_t)r * DM) + lane; float ss = 0.f;
#pragma unroll
          for (int j = 0; j < 4; ++j) { const f32x4 v = xr[64 * j]; ss += (v[0] * v[0] + v[1] * v[1]) + (v[2] * v[2] + v[3] * v[3]);
              u32x2 w; w.x = pk2(v[0], v[1]); w.y = pk2(v[2], v[3]); *((u32x2*)(XB + (size_t)r * DM) + lane + 64 * j) = w; }
          ss = wave_sum(ss); if (lane == 0) rsx[r] = rsqrtf(ss * (1.f / DM) + EPS);
      }
      bf16* MN = (bf16*)(ws + WS_MEMN);
      for (int r = gw; r < MMEM; r += NGW) {
          const f32x4* xr = (const f32x4*)(((const float*)a.in[1]) + (size_t)r * DM) + lane; f32x4 v[4]; float ss = 0.f;
#pragma unroll
          for (int j = 0; j < 4; ++j) { v[j] = xr[64 * j]; ss += (v[j][0] * v[j][0] + v[j][1] * v[j][1]) + (v[j][2] * v[j][2] + v[j][3] * v[j][3]); }
          ss = wave_sum(ss); const float rn = rsqrtf(ss * (1.f / DM) + EPS);
#pragma unroll
          for (int j = 0; j < 4; ++j) { const f32x4 g = *((const f32x4*)((const float*)a.in[3]) + lane + 64 * j); const f32x4 o = v[j] * rn * g;
              u32x2 w; w.x = pk2(o[0], o[1]); w.y = pk2(o[2], o[3]); *((u32x2*)(MN + (size_t)r * DM) + lane + 64 * j) = w; }
      }
    }
}

DI void res_phase(const float* xsrc, float* out, unsigned char* ws, int gidx, int G) {
    const bf16* Y = (const bf16*)(ws + WS_Y); const float* ysq = (const float*)(ws + WS_YSQ); const float* gpost = (const float*)(ws + WS_PAR) + PAR_GPOST + gidx * DM; bf16* XB = (bf16*)(ws + WS_XB); float* rsx = (float*)(ws + WS_RS);
    const int tid = opaque_tid(), lane = tid & 63, wave = tid >> 6;
    const int gw = opaque_bid() * NWAVES + wave, NGW = G * NWAVES;
    f32x4 g4[4];
#pragma unroll
    for (int j = 0; j < 4; ++j) g4[j] = *((const f32x4*)gpost + lane + 64 * j);
    for (int r = gw; r < M; r += NGW) {
        float ysum = 0.f;
#pragma unroll
        for (int j = 0; j < 4; ++j) { const f32x4 q = *((const f32x4*)(ysq + (size_t)r * 16) + j); ysum += (q[0] + q[1]) + (q[2] + q[3]); }
        const float rn = rsqrtf(ysum * (1.f / DM) + EPS);
        float ss = 0.f;
#pragma unroll
        for (int j = 0; j < 4; ++j) {
            const f32x4 xv = *((const f32x4*)(xsrc + (size_t)r * DM) + lane + 64 * j);
            const u32x2 yw = *((const u32x2*)(Y + (size_t)r * DM) + lane + 64 * j);
            f32x4 yv; yv[0] = bf2f(yw.x & 0xffffu); yv[1] = bf2f(yw.x >> 16); yv[2] = bf2f(yw.y & 0xffffu); yv[3] = bf2f(yw.y >> 16);
            const f32x4 xn = xv + yv * rn * g4[j];
            ss += (xn[0] * xn[0] + xn[1] * xn[1]) + (xn[2] * xn[2] + xn[3] * xn[3]);
            *((f32x4*)(out + (size_t)r * DM) + lane + 64 * j) = xn;
            u32x2 w; w.x = pk2(xn[0], xn[1]); w.y = pk2(xn[2], xn[3]); *((u32x2*)(XB + (size_t)r * DM) + lane + 64 * j) = w;
        }
        ss = wave_sum(ss);
        if (lane == 0) rsx[r] = rsqrtf(ss * (1.f / DM) + EPS);
    }
}

DI void mixer_phase(unsigned char* ws, int l, LAS unsigned char* lds, int G) {
    const bf16* U = (const bf16*)(ws + WS_U); const bf16* VNT = (const bf16*)(ws + WS_VNT); const bf16* P = (const bf16*)(ws + WS_P);
    const bf16* Q = (const bf16*)(ws + WS_Q); const bf16* Kb = (const bf16*)(ws + WS_K); const bf16* VT = (const bf16*)(ws + WS_VT);
    bf16* MIX = (bf16*)(ws + WS_BUFA);
    const bf16* WMk = (const bf16*)(ws + WS_WM) + (size_t)l * 4 * 128 * 128; const bf16* PWT = (const bf16*)(ws + WS_PWT) + (size_t)l * 4 * 64 * 64;
    const float* par = (const float*)(ws + WS_PAR); const float* bs = par + PAR_BS + l * 512; const float* pscale = par + PAR_PSC + l * 256; const float* sinks = par + PAR_SNK + l * 8;
    const int tid = opaque_tid(), lane = tid & 63, wave = __builtin_amdgcn_readfirstlane(tid >> 6), c32 = lane & 31, h = lane >> 5;
    LAS unsigned char* Ks = lds; LAS unsigned char* Vs = lds + 36864;
    for (int blk = opaque_bid(); blk < M / 128; blk += G) {
        const int row0 = blk * 128, b = blk >> 5, nb = blk & 31;
        const int tt = wave >> 1, dtile = wave & 1;
#pragma unroll 1
        for (int g = 0; g < 4; ++g) {
            f32x16 acc;
#pragma unroll
            for (int i = 0; i < 16; ++i) acc[i] = 0.f;
            const bf16* Wrow = WMk + ((size_t)(g * 128 + 32 * tt + c32)) * 128 + 8 * h;
            const bf16* Vrow = VNT + ((size_t)(blk * 4 + g) * 64 + 32 * dtile + c32) * 128 + 8 * h;
            for (int ks = 0; ks <= 2 * tt + 1; ++ks) { const bf16x8 af = *(const bf16x8*)(Wrow + 16 * ks); const bf16x8 bfr = *(const bf16x8*)(Vrow + 16 * ks); acc = MFMA32(af, bfr, acc); }
            const int d = g * 64 + 32 * dtile + c32;
#pragma unroll
            for (int i = 0; i < 16; ++i) { const int t = 32 * tt + crow(i, h); const size_t r = (size_t)(row0 + t);
                const float mixed = acc[i] + bs[g * 128 + t]; const float uu = bf2f(U[r * 256 + d]);
                MIX[r * 1024 + d] = f2bf1(uu * mixed); }
        }
#pragma unroll 1
        for (int g = 0; g < 4; ++g) {
            const int w = 2 << g;
            f32x16 acc;
#pragma unroll
            for (int i = 0; i < 16; ++i) acc[i] = 0.f;
            const int t = 32 * tt + c32, tpos = nb * 128 + t; const int cnt = (tpos + 1 < w) ? (tpos + 1) : w; const float icnt = 1.f / (float)cnt;
#pragma unroll 1
            for (int ks = 0; ks < 4; ++ks) {
                const bf16* prow = P + (size_t)(row0 + t) * 256 + g * 64 + 16 * ks + 8 * h;
                float sum[8], own[8];
#pragma unroll
                for (int e = 0; e < 8; ++e) sum[e] = 0.f;
                for (int k = 0; k < cnt; ++k) { const u32x4 v = *(const u32x4*)(prow - (size_t)k * 256);
                    float f[8]; f[0] = bf2f(v.x & 0xffffu); f[1] = bf2f(v.x >> 16); f[2] = bf2f(v.y & 0xffffu); f[3] = bf2f(v.y >> 16); f[4] = bf2f(v.z & 0xffffu); f[5] = bf2f(v.z >> 16); f[6] = bf2f(v.w & 0xffffu); f[7] = bf2f(v.w >> 16);
#pragma unroll
                    for (int e = 0; e < 8; ++e) { sum[e] += f[e]; if (k == 0) own[e] = f[e]; } }
                u32x4 pa; pa.x = pk2(sum[0] * icnt - own[0], sum[1] * icnt - own[1]); pa.y = pk2(sum[2] * icnt - own[2], sum[3] * icnt - own[3]);
                pa.z = pk2(sum[4] * icnt - own[4], sum[5] * icnt - own[5]); pa.w = pk2(sum[6] * icnt - own[6], sum[7] * icnt - own[7]);
                const bf16x8 af = __builtin_bit_cast(bf16x8, pa);
                const bf16x8 bfr = *(const bf16x8*)(PWT + ((size_t)(g * 64 + 32 * dtile + c32)) * 64 + 16 * ks + 8 * h);
                acc = MFMA32(af, bfr, acc);
            }
            const int d = g * 64 + 32 * dtile + c32; const float psc = pscale[d];
#pragma unroll
            for (int i = 0; i < 16; ++i) { const size_t r = (size_t)(row0 + 32 * tt + crow(i, h)); MIX[r * 1024 + 256 + d] = f2bf1(acc[i] * psc); }
        }
#pragma unroll 1
        for (int hv = 0; hv < 2; ++hv) {
            __syncthreads();
#pragma unroll
            for (int it = 0; it < 4; ++it) { const int id = tid + NTHREADS * it;
                { const int kk = id >> 3, ch = id & 7; u32x4 v = {0u, 0u, 0u, 0u};
                  if (nb > 0 || kk >= 128) v = *(const u32x4*)(Kb + (size_t)(row0 - 128 + kk) * 128 + hv * 64 + ch * 8);
                  *(LAS u32x4*)(Ks + kk * 144 + ch * 16) = v; }
                { const int d = id >> 5, ch = id & 31; u32x4 v = {0u, 0u, 0u, 0u};
                  if (nb > 0 || ch >= 16) v = *(const u32x4*)(VT + ((size_t)((b * 2 + hv) * 32 + nb - 1 + (ch >> 4)) * 64 + d) * 128 + (ch & 15) * 8);
                  *(LAS u32x4*)(Vs + d * 528 + ch * 16) = v; } }
            __syncthreads();
#pragma unroll 1
            for (int it = 0; it < 2; ++it) {
                const int qh = wave & 3, sb = (wave >> 2) + 2 * it, head = 4 * hv + qh;
                const size_t r = (size_t)(row0 + 32 * sb + c32);
                bf16x8 qf[4];
#pragma unroll
                for (int st = 0; st < 4; ++st) qf[st] = *(const bf16x8*)(Q + r * 512 + head * 64 + 16 * st + 8 * h);
                f32x16 S[5];
#pragma unroll
                for (int kt = 0; kt < 5; ++kt) {
#pragma unroll
                    for (int i = 0; i < 16; ++i) S[kt][i] = 0.f;
#pragma unroll
                    for (int st = 0; st < 4; ++st) { const bf16x8 kf = *(const LAS bf16x8*)(Ks + (32 * (sb + kt) + c32) * 144 + (16 * st + 8 * h) * 2); S[kt] = MFMA32(kf, qf[st], S[kt]); }
                }
                const float sink = sinks[head] * LOG2E;
                float mx = sink;
#pragma unroll
                for (int kt = 0; kt < 5; ++kt)
#pragma unroll
                    for (int i = 0; i < 16; ++i) { const int krel = 32 * kt + crow(i, h);
                        const bool valid = (krel > c32) && (krel <= c32 + 128) && (nb > 0 || 32 * sb + krel >= 128);
                        const float sv = valid ? S[kt][i] : -INFINITY; S[kt][i] = sv; mx = fmaxf(mx, sv); }
                mx = fmaxf(mx, __shfl_xor(mx, 32));
                float sum = 0.f;
#pragma unroll
                for (int kt = 0; kt < 5; ++kt)
#pragma unroll
                    for (int i = 0; i < 16; ++i) { const float e = __builtin_amdgcn_exp2f(S[kt][i] - mx); S[kt][i] = e; sum += e; }
                sum += __shfl_xor(sum, 32); sum += __builtin_amdgcn_exp2f(sink - mx);
                const float inv = 1.f / sum;
                f32x16 O[2];
#pragma unroll
                for (int i = 0; i < 16; ++i) { O[0][i] = 0.f; O[1][i] = 0.f; }
#pragma unroll
                for (int kt = 0; kt < 5; ++kt)
#pragma unroll
                    for (int s = 0; s < 2; ++s) {
                        u32x4 pw; pw.x = pk2(S[kt][8 * s + 0], S[kt][8 * s + 1]); pw.y = pk2(S[kt][8 * s + 2], S[kt][8 * s + 3]); pw.z = pk2(S[kt][8 * s + 4], S[kt][8 * s + 5]); pw.w = pk2(S[kt][8 * s + 6], S[kt][8 * s + 7]);
                        const bf16x8 pf = __builtin_bit_cast(bf16x8, pw);
#pragma unroll
                        for (int dt = 0; dt < 2; ++dt) { const LAS unsigned char* vp = Vs + (32 * dt + c32) * 528 + (32 * (sb + kt) + 16 * s + 4 * h) * 2;
                            const u32x2 lo = *(const LAS u32x2*)vp, hi = *(const LAS u32x2*)(vp + 16);
                            u32x4 vv; vv.x = lo.x; vv.y = lo.y; vv.z = hi.x; vv.w = hi.y;
                            O[dt] = MFMA32(__builtin_bit_cast(bf16x8, vv), pf, O[dt]); }
                    }
#pragma unroll
                for (int dt = 0; dt < 2; ++dt)
#pragma unroll
                    for (int g4 = 0; g4 < 4; ++g4) { u32x2 w; w.x = pk2(O[dt][4 * g4] * inv, O[dt][4 * g4 + 1] * inv); w.y = pk2(O[dt][4 * g4 + 2] * inv, O[dt][4 * g4 + 3] * inv);
                        *(u32x2*)(MIX + r * 1024 + 512 + head * 64 + 32 * dt + 8 * g4 + 4 * h) = w; }
            }
        }
        __syncthreads();
    }
}

DI void xattn_phase(unsigned char* ws, int l, LAS unsigned char* lds, int G) {
    bf16* QX = (bf16*)(ws + WS_BUFA);
    const bf16* KM = (const bf16*)(ws + WS_KM) + (size_t)l * MMEM * DM; const bf16* VTM = (const bf16*)(ws + WS_VTM) + (size_t)l * MMEM * DM;
    const int tid = opaque_tid(), lane = tid & 63, wave = __builtin_amdgcn_readfirstlane(tid >> 6), c32 = lane & 31, h = lane >> 5;
    for (int item = opaque_bid(); item < NBATCH * 4 * 16; item += G) {
        const int qc = item & 15, head = (item >> 4) & 3, b = item >> 6;
        __syncthreads();
#pragma unroll 4
        for (int it = 0; it < 16; ++it) { const int id = tid + NTHREADS * it, mrow = id >> 5, ch = id & 31;
            *(LAS u32x4*)(lds + mrow * 528 + ch * 16) = *(const u32x4*)(KM + (size_t)(b * 256 + mrow) * 1024 + head * 256 + ch * 8); }
        __syncthreads();
        const size_t r = (size_t)b * SEQ + qc * 256 + 32 * wave + c32;
        f32x16 S[8];
#pragma unroll
        for (int mt = 0; mt < 8; ++mt)
#pragma unroll
            for (int i = 0; i < 16; ++i) S[mt][i] = 0.f;
#pragma unroll 2
        for (int st = 0; st < 16; ++st) { const bf16x8 qf = *(const bf16x8*)(QX + r * 1024 + head * 256 + 16 * st + 8 * h);
#pragma unroll
            for (int mt = 0; mt < 8; ++mt) { const bf16x8 kf = *(const LAS bf16x8*)(lds + (32 * mt + c32) * 528 + (16 * st + 8 * h) * 2); S[mt] = MFMA32(kf, qf, S[mt]); } }
        float mx = -INFINITY;
#pragma unroll
        for (int mt = 0; mt < 8; ++mt)
#pragma unroll
            for (int i = 0; i < 16; ++i) mx = fmaxf(mx, S[mt][i]);
        mx = fmaxf(mx, __shfl_xor(mx, 32));
        float sum = 0.f; bf16x8 pf[8][2];
#pragma unroll
        for (int mt = 0; mt < 8; ++mt) {
#pragma unroll
            for (int i = 0; i < 16; ++i) { const float e = __builtin_amdgcn_exp2f(S[mt][i] - mx); S[mt][i] = e; sum += e; }
#pragma unroll
            for (int s = 0; s < 2; ++s) { u32x4 pw; pw.x = pk2(S[mt][8 * s + 0], S[mt][8 * s + 1]); pw.y = pk2(S[mt][8 * s + 2], S[mt][8 * s + 3]); pw.z = pk2(S[mt][8 * s + 4], S[mt][8 * s + 5]); pw.w = pk2(S[mt][8 * s + 6], S[mt][8 * s + 7]);
                pf[mt][s] = __builtin_bit_cast(bf16x8, pw); }
        }
        sum += __shfl_xor(sum, 32);
        const float inv = 1.f / sum;
        __syncthreads();
#pragma unroll 4
        for (int it = 0; it < 16; ++it) { const int id = tid + NTHREADS * it, d = id >> 5, ch = id & 31;
            *(LAS u32x4*)(lds + d * 528 + ch * 16) = *(const u32x4*)(VTM + ((size_t)(b * 4 + head) * 256 + d) * 256 + ch * 8); }
        __syncthreads();
#pragma unroll 1
        for (int dt = 0; dt < 8; ++dt) {
            f32x16 O;
#pragma unroll
            for (int i = 0; i < 16; ++i) O[i] = 0.f;
#pragma unroll
            for (int mt = 0; mt < 8; ++mt)
#pragma unroll
                for (int s = 0; s < 2; ++s) { const LAS unsigned char* vp = lds + (32 * dt + c32) * 528 + (32 * mt + 16 * s + 4 * h) * 2;
                    const u32x2 lo = *(const LAS u32x2*)vp, hi = *(const LAS u32x2*)(vp + 16);
                    u32x4 vv; vv.x = lo.x; vv.y = lo.y; vv.z = hi.x; vv.w = hi.y;
                    O = MFMA32(__builtin_bit_cast(bf16x8, vv), pf[mt][s], O); }
#pragma unroll
            for (int g4 = 0; g4 < 4; ++g4) { u32x2 w; w.x = pk2(O[4 * g4] * inv, O[4 * g4 + 1] * inv); w.y = pk2(O[4 * g4 + 2] * inv, O[4 * g4 + 3] * inv);
                *(u32x2*)(QX + r * 1024 + head * 256 + 32 * dt + 8 * g4 + 4 * h) = w; }
        }
    }
    __syncthreads();
}

#ifndef PG8_SP2
#define PG8_SP2 true
#endif
#ifndef PG8_ALIGN
#define PG8_ALIGN true
#endif
constexpr int N_PHASES = 2 + 11 * DEPTH;

__global__ void __launch_bounds__(NTHREADS, 2) mk_fwd(Args a) {
    extern __shared__ __attribute__((aligned(16))) unsigned char lds_raw[];
    LAS unsigned char* lds = (LAS unsigned char*)lds_raw;
    cg::grid_group grid = cg::this_grid();
    const int G = gridDim.x, lo = a.ph_lo, hi = a.ph_hi;
    unsigned char* ws = a.ws;
#define IN(k) (lo <= (k) && (k) < hi)
#define SEAM(k) do { if (IN((k) + 1)) grid.sync(); } while (0)
    if (IN(0)) { prologue(a, lds, G); SEAM(0); }
    if (IN(1)) {
        pg8::Gemm g{(const pg8::bf16_t*)(ws + WS_MEMN), (const pg8::bf16_t*)(ws + WS_WXKV), MMEM, DEPTH * 2 * DM, DM}; pg8::StaticOrder S; S.init(MMEM, DEPTH * 2 * DM, G, opaque_bid());
        pg8::EpiKV E{ws};
        pg8::gemm_phase<pg8::EpiKV, pg8::StaticOrder, false, PG8_SP2>(lds, g, S, E);
        SEAM(1);
    }
#pragma unroll 1
    for (int l = 0; l < DEPTH; ++l) {
        const int p0 = 2 + 11 * l;
        if (IN(p0 + 0)) {
            pg8::Gemm g{(const pg8::bf16_t*)(ws + WS_XB), (const pg8::bf16_t*)(ws + WS_WIN) + (size_t)l * D_IN * DM, M, D_IN, DM}; pg8::StaticOrder S; S.init(M, D_IN, G, opaque_bid());
            pg8::EpiIn E{ws, l};
            pg8::gemm_phase<pg8::EpiIn, pg8::StaticOrder, PG8_ALIGN, PG8_SP2>(lds, g, S, E);
            SEAM(p0 + 0);
        }
        if (IN(p0 + 1)) { mixer_phase(ws, l, lds, G); SEAM(p0 + 1); }
        if (IN(p0 + 2)) {
            pg8::Gemm g{(const pg8::bf16_t*)(ws + WS_BUFA), (const pg8::bf16_t*)(ws + WS_WO) + (size_t)l * DM * DM, M, DM, DM}; pg8::StaticOrder S; S.init(M, DM, G, opaque_bid());
            pg8::EpiY E{ws};
            pg8::gemm_phase<pg8::EpiY, pg8::StaticOrder, PG8_ALIGN, PG8_SP2>(lds, g, S, E);
            SEAM(p0 + 2);
        }
        if (IN(p0 + 3)) { res_phase(l == 0 ? (const float*)a.in[0] : a.out, a.out, ws, l * 3 + 0, G); SEAM(p0 + 3); }
        if (IN(p0 + 4)) {
            pg8::Gemm g{(const pg8::bf16_t*)(ws + WS_XB), (const pg8::bf16_t*)(ws + WS_WXQ) + (size_t)l * DM * DM, M, DM, DM}; pg8::StaticOrder S; S.init(M, DM, G, opaque_bid());
            pg8::EpiQx E{ws};
            pg8::gemm_phase<pg8::EpiQx, pg8::StaticOrder, PG8_ALIGN, PG8_SP2>(lds, g, S, E);
            SEAM(p0 + 4);
        }
        if (IN(p0 + 5)) { xattn_phase(ws, l, lds, G); SEAM(p0 + 5); }
        if (IN(p0 + 6)) {
            pg8::Gemm g{(const pg8::bf16_t*)(ws + WS_BUFA), (const pg8::bf16_t*)(ws + WS_WXO) + (size_t)l * DM * DM, M, DM, DM}; pg8::StaticOrder S; S.init(M, DM, G, opaque_bid());
            pg8::EpiY E{ws};
            pg8::gemm_phase<pg8::EpiY, pg8::StaticOrder, PG8_ALIGN, PG8_SP2>(lds, g, S, E);
            SEAM(p0 + 6);
        }
        if (IN(p0 + 7)) { res_phase(a.out, a.out, ws, l * 3 + 1, G); SEAM(p0 + 7); }
        if (IN(p0 + 8)) {
            pg8::Gemm g{(const pg8::bf16_t*)(ws + WS_XB), (const pg8::bf16_t*)(ws + WS_WGU) + (size_t)l * 2 * D_FF * DM, M, 2 * D_FF, DM}; pg8::StaticOrder S; S.init(M, 2 * D_FF, G, opaque_bid());
            pg8::EpiGU E{ws};
            pg8::gemm_phase<pg8::EpiGU, pg8::StaticOrder, PG8_ALIGN, PG8_SP2>(lds, g, S, E);
            SEAM(p0 + 8);
        }
        if (IN(p0 + 9)) {
            pg8::Gemm g{(const pg8::bf16_t*)(ws + WS_F), (const pg8::bf16_t*)(ws + WS_WDN) + (size_t)l * DM * D_FF, M, DM, D_FF}; pg8::StaticOrder S; S.init(M, DM, G, opaque_bid());
            pg8::EpiY E{ws};
            pg8::gemm_phase<pg8::EpiY, pg8::StaticOrder, PG8_ALIGN, PG8_SP2>(lds, g, S, E);
            SEAM(p0 + 9);
        }
        if (IN(p0 + 10)) { res_phase(a.out, a.out, ws, l * 3 + 2, G); SEAM(p0 + 10); }
    }
#undef IN
#undef SEAM
}

extern "C" void kernel_launch(void* const* d_in, const int* in_sizes, int n_in, void* d_out, int out_size, void* d_ws, size_t ws_size, hipStream_t stream) {
    static int grid = 0;
    if (grid == 0) {
        if (n_in != 23 || in_sizes[0] != M * DM || out_size != M * DM || ws_size < WS_END) { fprintf(stderr, "kernel_launch: unexpected shapes (n_in %d, in0 %d, out %d, ws %zu < %zu)\n", n_in, n_in > 0 ? in_sizes[0] : -1, out_size, ws_size, (size_t)WS_END); grid = -1; return; }
        int dev = 0, cus = 0, per_cu = 0;
        (void)hipGetDevice(&dev); (void)hipDeviceGetAttribute(&cus, hipDeviceAttributeMultiprocessorCount, dev);
        if (hipFuncSetAttribute((const void*)mk_fwd, hipFuncAttributeMaxDynamicSharedMemorySize, LDS_BYTES) != hipSuccess) fprintf(stderr, "kernel_launch: hipFuncSetAttribute failed\n");
        if (hipOccupancyMaxActiveBlocksPerMultiprocessor(&per_cu, (const void*)mk_fwd, NTHREADS, LDS_BYTES) != hipSuccess || per_cu < 1) { fprintf(stderr, "kernel_launch: occupancy query says %d; using 1 per CU\n", per_cu); per_cu = 1; }
        (void)hipGetLastError();
        grid = cus * per_cu; if (grid <= 0) grid = 256;
    }
    if (grid < 0) return;
    Args a{};
    for (int i = 0; i < 23; ++i) a.in[i] = d_in[i];
    a.out = (float*)d_out; a.ws = (unsigned char*)d_ws;
#if MK_PER_PHASE
    for (int ph = 0; ph < N_PHASES; ++ph) { a.ph_lo = ph; a.ph_hi = ph + 1; hipLaunchKernelGGL(mk_fwd, dim3(grid), dim3(NTHREADS), LDS_BYTES, stream, a); }
#else
    a.ph_lo = 0; a.ph_hi = N_PHASES;
    void* args[] = {&a};
    const hipError_t e = hipLaunchCooperativeKernel((const void*)mk_fwd, dim3(grid), dim3(NTHREADS), args, LDS_BYTES, stream);
    if (e != hipSuccess) fprintf(stderr, "kernel_launch: cooperative launch failed: %s (grid %d)\n", hipGetErrorString(e), grid);
#endif
}
```

```cpp
#include <hip/hip_runtime.h>
#include <hip/hip_cooperative_groups.h>
#include <cstdio>
#include <cstdint>
namespace cg = cooperative_groups;

#ifndef MK_PER_PHASE
#define MK_PER_PHASE 0
#endif

typedef __attribute__((address_space(3))) unsigned char lds_u8;
constexpr int DM = 1024, NBATCH = 8, SEQ = 4096, DEPTH = 4, MEML = 256, M = NBATCH * SEQ, MMEM = NBATCH * MEML, D_IN = 1536, D_FF = 2816;
constexpr float EPS = 1e-6f, LOG2E = 1.4426950408889634f;
constexpr int NWAVES = 8, NTHREADS = 512;
constexpr int LDS_BYTES = 147456;
constexpr size_t MiB = 1u << 20;
constexpr size_t WS_WIN = 0, WS_WO = 12 * MiB, WS_WXQ = 20 * MiB, WS_WXO = 28 * MiB, WS_WGU = 36 * MiB, WS_WDN = 80 * MiB, WS_WXKV = 102 * MiB;
constexpr size_t WS_WM = 118 * MiB, WS_PWT = WS_WM + 512 * 1024, WS_RS = WS_PWT + 128 * 1024, WS_YSQ = 468 * MiB;
constexpr size_t WS_PAR = WS_RS + 128 * 1024, PAR_VG = 0, PAR_BS = 1024, PAR_PSC = 3072, PAR_SNK = 4096, PAR_GPOST = 4160;
constexpr size_t WS_COS = 120 * MiB, WS_SIN = 124 * MiB, WS_KM = 128 * MiB, WS_VTM = 144 * MiB, WS_MEMN = 160 * MiB, WS_XB = 164 * MiB, WS_Y = 228 * MiB, WS_R = 292 * MiB;
constexpr size_t WS_U = WS_R, WS_VNT = WS_R + 16 * MiB, WS_P = WS_R + 32 * MiB, WS_Q = WS_R + 48 * MiB, WS_K = WS_R + 80 * MiB, WS_VT = WS_R + 88 * MiB, WS_BUFA = WS_R + 96 * MiB, WS_F = WS_R;
constexpr size_t WS_BAR = WS_YSQ + 2 * MiB;
constexpr size_t WS_END = WS_BAR + 1 * MiB;
static_assert(WS_YSQ == WS_R + 176 * MiB && WS_PAR + (PAR_GPOST + DEPTH * 3 * DM) * 4 <= WS_COS, "ws map");
static_assert((size_t)M * D_FF * 2 <= 176 * MiB, "f fits");


namespace pg8 {
#define PG8_LAS __attribute__((address_space(3)))
typedef unsigned short bf16_t;
typedef short bf16x8 __attribute__((ext_vector_type(8)));
typedef float f32x4 __attribute__((ext_vector_type(4)));
typedef unsigned u32x4 __attribute__((ext_vector_type(4)));
constexpr int BM = 256, BK = 64, HALF = 128, HTB = HALF * BK * 2  , STAGE_BYTES = 8 * HTB, NXCD = 8, WGM = 8;

__host__ __device__ __forceinline__ int lds_byte(int r, int c) { const int st = (r >> 4) * 2 + (c >> 5), rr = r & 15, cc = c & 31, ob = rr * 64 + cc * 2; return st * 1024 + (ob ^ (((ob >> 9) & 1) << 5)); }
__host__ __device__ __forceinline__ void stage_rc(int b, int& R, int& C) { const int st = b / 1024, sb = b % 1024, swz = sb ^ (((sb >> 9) & 1) << 5); R = (st >> 1) * 16 + swz / 64; C = (st & 1) * 32 + (swz % 64) / 2; }
__host__ __device__ __forceinline__ int perm32(int rho) { const int n = rho >> 4, i = rho & 15; return 8 * (i >> 2) + 4 * n + (i & 3); }

struct Unit { int pm, pn; };
struct Gemm { const bf16_t* A; const bf16_t* Bt; int M, N, K; };

struct StaticOrder {
    int nM, nN, nwg, G, c;
    __host__ __device__ void init(int M, int N, int G_, int c_) { nM = M / BM; nN = N / BM; nwg = nM * nN; G = G_; c = c_; }
    __host__ __device__ bool next(int i, Unit& u) const {
        const long L = (long)i * G + c; if (L >= nwg) return false;
        int wgid = (int)L; { const int q = nwg / NXCD, r = nwg % NXCD, xcd = wgid % NXCD, off = wgid / NXCD; wgid = (xcd < r ? xcd * (q + 1) : r * (q + 1) + (xcd - r) * q) + off; }
        const int nig = WGM * nN, gid = wgid / nig, fm = gid * WGM, gsz = (nM - fm) < WGM ? (nM - fm) : WGM;
        u.pm = fm + ((wgid % nig) % gsz); u.pn = (wgid % nig) / gsz; return true;
    }
    __device__ __forceinline__ void a_ready(const Unit&) const {}
    __device__ __forceinline__ void done(const Unit&) const {}
};


typedef unsigned u32x2 __attribute__((ext_vector_type(2)));
typedef float f32x2 __attribute__((ext_vector_type(2)));
typedef __bf16 bf16v2 __attribute__((ext_vector_type(2)));
__device__ __forceinline__ unsigned pk2(float lo, float hi) { f32x2 v = {lo, hi}; bf16v2 b = __builtin_convertvector(v, bf16v2); return __builtin_bit_cast(unsigned, b); }
__device__ __forceinline__ bf16_t f2bf1(float v) { return (bf16_t)(pk2(v, 0.f) & 0xffffu); }
__device__ __forceinline__ u32x4 pk8(const f32x4 a, const f32x4 b) { u32x4 w; w.x = pk2(a[0], a[1]); w.y = pk2(a[2], a[3]); w.z = pk2(b[0], b[1]); w.w = pk2(b[2], b[3]); return w; }
__device__ __forceinline__ float gelu_tanh(float x) {
    const float u = x * (1.f + 0.044715f * x * x);
    const float e = __builtin_amdgcn_exp2f(u * (-2.f * 0.7978845608028654f * 1.4426950408889634f));
    return x * __builtin_amdgcn_rcpf(1.f + e);
}
__device__ __forceinline__ float silu_f(float x) { return x * __builtin_amdgcn_rcpf(1.f + __builtin_amdgcn_exp2f(x * -1.4426950408889634f)); }
constexpr float NORM_EPS = 1e-6f;
constexpr float QSCALE_SWA = 0.125f * 1.4426950408889634f;
constexpr float QSCALE_X = 0.0625f * 1.4426950408889634f;

struct EpiIn {
    static constexpr bool PERM = true, AFTER_DRAIN = false;
    unsigned char* ws; int l;
    __device__ __forceinline__ void operator()(const f32x4 (&acc)[2][2][4][2], const Unit& u, int wr, int wc, int fr, int fq) const {
        asm volatile("" : "+v"(fr), "+v"(fq), "+s"(wr), "+s"(wc));
        const float* rs = (const float*)(ws + WS_RS); bf16_t* U = (bf16_t*)(ws + WS_U); bf16_t* VNT = (bf16_t*)(ws + WS_VNT); bf16_t* P = (bf16_t*)(ws + WS_P); bf16_t* Q = (bf16_t*)(ws + WS_Q);
        bf16_t* Kb = (bf16_t*)(ws + WS_K); bf16_t* VT = (bf16_t*)(ws + WS_VT); const float* vgain = (const float*)(ws + WS_PAR) + PAR_VG + l * 256;
        const float* cosT = (const float*)(ws + WS_COS); const float* sinT = (const float*)(ws + WS_SIN);
        const int pn = u.pn;
        const int rbase = u.pm * BM + wr * 64 + fr;
        if (pn == 0 || pn == 2) {
            bf16_t* O = (pn == 0) ? U : P;
#pragma unroll
            for (int ai = 0; ai < 2; ++ai)
#pragma unroll
                for (int m = 0; m < 4; ++m) { const int r = rbase + ai * HALF + m * 16; const float s = rs[r];
#pragma unroll
                    for (int bj = 0; bj < 2; ++bj) { f32x4 v0 = acc[ai][bj][m][0] * s, v1 = acc[ai][bj][m][1] * s;
                        if (pn == 0) {
#pragma unroll
                            for (int j = 0; j < 4; ++j) { v0[j] = gelu_tanh(v0[j]); v1[j] = gelu_tanh(v1[j]); } }
                        *(u32x4*)(O + (size_t)r * 256 + bj * HALF + wc * 32 + fq * 8) = pk8(v0, v1); } asm volatile("" ::: "memory"); }
        } else if (pn == 1) {
            const int g = wc;
#pragma unroll
            for (int ai = 0; ai < 2; ++ai)
#pragma unroll
                for (int m = 0; m < 4; ++m) { const int r = rbase + ai * HALF + m * 16; const float s = rs[r];
                    float v[2][2][4]; float ss = 0.f;
#pragma unroll
                    for (int bj = 0; bj < 2; ++bj)
#pragma unroll
                        for (int n = 0; n < 2; ++n)
#pragma unroll
                            for (int j = 0; j < 4; ++j) { const float t = gelu_tanh(acc[ai][bj][m][n][j] * s); v[bj][n][j] = t; ss += t * t; }
                    ss += __shfl_xor(ss, 16); ss += __shfl_xor(ss, 32);
                    const float rn = rsqrtf(ss * (1.f / 64.f) + NORM_EPS);
                    const int chunk = r >> 7, sidx = r & 127;
                    bf16_t* base = VNT + ((size_t)(chunk * 4 + g) * 64) * 128 + sidx;
#pragma unroll
                    for (int bj = 0; bj < 2; ++bj)
#pragma unroll
                        for (int n = 0; n < 2; ++n)
#pragma unroll
                            for (int j = 0; j < 4; ++j) { const int dd = 32 * bj + 8 * fq + 4 * n + j;
                                base[(size_t)dd * 128] = f2bf1(v[bj][n][j] * rn * vgain[g * 64 + dd]); } asm volatile("" ::: "memory"); }
        } else {
            const int ii = 4 * (wc & 1) + fq;
#pragma unroll
            for (int ai = 0; ai < 2; ++ai)
#pragma unroll
                for (int m = 0; m < 4; ++m) { const int r = rbase + ai * HALF + m * 16; const float s = rs[r];
                    const f32x4 c4 = *(const f32x4*)(cosT + (size_t)r * 32 + 4 * ii), s4 = *(const f32x4*)(sinT + (size_t)r * 32 + 4 * ii);
#pragma unroll
                    for (int bj = 0; bj < 2; ++bj) {
                        if (pn == 5 && bj == 1) {
                            const int hv = wc >> 1, b = r >> 12, nblk = (r >> 7) & 31;
                            bf16_t* base = VT + ((size_t)((b * 2 + hv) * 32 + nblk) * 64 + 32 * (wc & 1) + 8 * fq) * 128 + (r & 127);
#pragma unroll
                            for (int n = 0; n < 2; ++n)
#pragma unroll
                                for (int j = 0; j < 4; ++j) base[(4 * n + j) * 128] = f2bf1(acc[ai][bj][m][n][j] * s);
                        } else {
                            const float sc = (pn == 5) ? s : s * QSCALE_SWA;
                            const f32x4 x1 = acc[ai][bj][m][0] * sc, x2 = acc[ai][bj][m][1] * sc;
                            const f32x4 o1 = x1 * c4 - x2 * s4, o2 = x2 * c4 + x1 * s4;
                            bf16_t* dst = (pn == 5) ? (Kb + (size_t)r * 128 + wc * 32 + fq * 8) : (Q + (size_t)r * 512 + (pn - 3) * 256 + bj * HALF + wc * 32 + fq * 8);
                            *(u32x4*)dst = pk8(o1, o2);
                        } } asm volatile("" ::: "memory"); }
        }
    }
};

struct EpiY {
    static constexpr bool PERM = true, AFTER_DRAIN = false;
    unsigned char* ws;
    __device__ __forceinline__ void operator()(const f32x4 (&acc)[2][2][4][2], const Unit& u, int wr, int wc, int fr, int fq) const {
        asm volatile("" : "+v"(fr), "+v"(fq), "+s"(wr), "+s"(wc));
        bf16_t* Y = (bf16_t*)(ws + WS_Y); float* ysq = (float*)(ws + WS_YSQ);
        const int rbase = u.pm * BM + wr * 64 + fr, cbase = u.pn * BM + wc * 32 + fq * 8;
#pragma unroll
        for (int ai = 0; ai < 2; ++ai)
#pragma unroll
            for (int m = 0; m < 4; ++m) { const int r = rbase + ai * HALF + m * 16; float ss = 0.f;
#pragma unroll
                for (int bj = 0; bj < 2; ++bj) { const f32x4 v0 = acc[ai][bj][m][0], v1 = acc[ai][bj][m][1];
                    ss += (v0[0] * v0[0] + v0[1] * v0[1]) + (v0[2] * v0[2] + v0[3] * v0[3]) + (v1[0] * v1[0] + v1[1] * v1[1]) + (v1[2] * v1[2] + v1[3] * v1[3]);
                    *(u32x4*)(Y + (size_t)r * 1024 + cbase + bj * HALF) = pk8(v0, v1); }
                ss += __shfl_xor(ss, 16); ss += __shfl_xor(ss, 32);
                if (fq == 0) ysq[(size_t)r * 16 + u.pn * 4 + wc] = ss; asm volatile("" ::: "memory"); }
    }
};

struct EpiQx {
    static constexpr bool PERM = true, AFTER_DRAIN = false;
    unsigned char* ws;
    __device__ __forceinline__ void operator()(const f32x4 (&acc)[2][2][4][2], const Unit& u, int wr, int wc, int fr, int fq) const {
        asm volatile("" : "+v"(fr), "+v"(fq), "+s"(wr), "+s"(wc));
        const float* rs = (const float*)(ws + WS_RS); bf16_t* O = (bf16_t*)(ws + WS_BUFA);
        const int rbase = u.pm * BM + wr * 64 + fr, cbase = u.pn * BM + wc * 32 + fq * 8;
#pragma unroll
        for (int ai = 0; ai < 2; ++ai)
#pragma unroll
            for (int m = 0; m < 4; ++m) { const int r = rbase + ai * HALF + m * 16; const float s = rs[r] * QSCALE_X;
#pragma unroll
                for (int bj = 0; bj < 2; ++bj) *(u32x4*)(O + (size_t)r * 1024 + cbase + bj * HALF) = pk8(acc[ai][bj][m][0] * s, acc[ai][bj][m][1] * s); }
    }
};

struct EpiKV {
    static constexpr bool PERM = true, AFTER_DRAIN = false;
    unsigned char* ws;
    __device__ __forceinline__ void operator()(const f32x4 (&acc)[2][2][4][2], const Unit& u, int wr, int wc, int fr, int fq) const {
        asm volatile("" : "+v"(fr), "+v"(fq), "+s"(wr), "+s"(wc));
        bf16_t* KM = (bf16_t*)(ws + WS_KM); bf16_t* VTM = (bf16_t*)(ws + WS_VTM);
        const int layer = u.pn >> 3, t = u.pn & 7;
        const int rbase = u.pm * BM + wr * 64 + fr;
#pragma unroll
        for (int ai = 0; ai < 2; ++ai)
#pragma unroll
            for (int m = 0; m < 4; ++m) { const int r = rbase + ai * HALF + m * 16;
#pragma unroll
                for (int bj = 0; bj < 2; ++bj) {
                    if (t < 4) *(u32x4*)(KM + ((size_t)layer * 2048 + r) * 1024 + t * 256 + bj * HALF + wc * 32 + fq * 8) = pk8(acc[ai][bj][m][0], acc[ai][bj][m][1]);
                    else { const int b = r >> 8, mm = r & 255, head = t - 4;
                        bf16_t* base = VTM + ((size_t)((layer * 8 + b) * 4 + head) * 256) * 256 + mm;
#pragma unroll
                        for (int n = 0; n < 2; ++n)
#pragma unroll
                            for (int j = 0; j < 4; ++j) { const int d = bj * HALF + wc * 32 + fq * 8 + 4 * n + j; base[(size_t)d * 256] = f2bf1(acc[ai][bj][m][n][j]); } } } }
    }
};

struct EpiGU {
    static constexpr bool PERM = true, AFTER_DRAIN = false;
    unsigned char* ws;
    __device__ __forceinline__ void operator()(const f32x4 (&acc)[2][2][4][2], const Unit& u, int wr, int wc, int fr, int fq) const {
        asm volatile("" : "+v"(fr), "+v"(fq), "+s"(wr), "+s"(wc));
        const float* rs = (const float*)(ws + WS_RS); bf16_t* F = (bf16_t*)(ws + WS_F);
        const int rbase = u.pm * BM + wr * 64 + fr, cbase = u.pn * 128 + wc * 16 + fq * 4;
#pragma unroll
        for (int ai = 0; ai < 2; ++ai)
#pragma unroll
            for (int m = 0; m < 4; ++m) { const int r = rbase + ai * HALF + m * 16; const float s = rs[r];
#pragma unroll
                for (int bj = 0; bj < 2; ++bj) { const f32x4 g = acc[ai][bj][m][0] * s, up = acc[ai][bj][m][1] * s;
                    u32x2 w; w.x = pk2(silu_f(g[0]) * up[0], silu_f(g[1]) * up[1]); w.y = pk2(silu_f(g[2]) * up[2], silu_f(g[3]) * up[3]);
                    *(u32x2*)(F + (size_t)r * 2816 + cbase + bj * 64) = w; } }
    }
};

template <class Epi, class Sched, bool ALIGN_EPI = false, bool SP2 = false>
__device__ __forceinline__ void gemm_phase(PG8_LAS unsigned char* lds, const Gemm g, const Sched& S, const Epi& E) {
    int tid_ = threadIdx.x; asm volatile("" : "+v"(tid_));
    const int tid = tid_, wid = __builtin_amdgcn_readfirstlane(tid >> 6), lane = tid & 63, wr = wid >> 2, wc = wid & 3, fr = lane & 15, fq = lane >> 4;
    const int K = g.K, nt = K / BK;
    unsigned voffA[2], voffB[2];
#pragma unroll
    for (int i = 0; i < 2; ++i) { int R, C; stage_rc(tid * 16 + i * 8192, R, C); const int Rb = Epi::PERM ? ((R & ~31) + perm32(R & 31)) : R;
        voffA[i] = (unsigned)(R * K + C) * 2u; voffB[i] = (unsigned)(Rb * K + C) * 2u; }
    const size_t kstep = (size_t)(BK * 2);
    const size_t hstep = (size_t)HALF * K * 2;
    const size_t tstep = 2 * hstep;
    const unsigned ldsw = (unsigned)wid * 1024u;
    const int aoff = lds_byte(wr * 64 + fr, fq * 8), boff = lds_byte(wc * 32 + fr, fq * 8);
#define PG8_SA(b, h) (((b) * 2 + (h)) * HTB)
#define PG8_SB(b, h) ((4 + (b) * 2 + (h)) * HTB)
#define PG8_STAGE(bufoff, gbase, voff) do { _Pragma("unroll") for (int _i = 0; _i < 2; ++_i) \
        __builtin_amdgcn_global_load_lds((const unsigned*)((const char*)(gbase) + (voff)[_i]), (PG8_LAS unsigned*)(lds + (bufoff) + ldsw + _i * 8192), 16, 0, 0); } while (0)
#define PG8_LDA(dst, b, h) do { _Pragma("unroll") for (int m = 0; m < 4; ++m) _Pragma("unroll") for (int k = 0; k < 2; ++k) dst[m][k] = *(const PG8_LAS bf16x8*)(lds + PG8_SA(b, h) + aoff + m * 2048 + k * 1024); } while (0)
#define PG8_LDB(dst, b, h) do { _Pragma("unroll") for (int n = 0; n < 2; ++n) _Pragma("unroll") for (int k = 0; k < 2; ++k) dst[n][k] = *(const PG8_LAS bf16x8*)(lds + PG8_SB(b, h) + boff + n * 2048 + k * 1024); } while (0)
#define PG8_MMA(ai, bj, At, Bt) do { __builtin_amdgcn_s_setprio(1); _Pragma("unroll") for (int m = 0; m < 4; ++m) _Pragma("unroll") for (int n = 0; n < 2; ++n) _Pragma("unroll") for (int k = 0; k < 2; ++k) \
        acc[ai][bj][m][n] = __builtin_amdgcn_mfma_f32_16x16x32_bf16(Bt[n][k], At[m][k], acc[ai][bj][m][n], 0, 0, 0); __builtin_amdgcn_s_setprio(0); } while (0)
#define PG8_WAIT_V(n) asm volatile("s_waitcnt vmcnt(" #n ")" ::: "memory")
#define PG8_WAIT_L(n) asm volatile("s_waitcnt lgkmcnt(" #n ")" ::: "memory")
#define PG8_BAR __builtin_amdgcn_s_barrier()
#define PG8_SCHED __builtin_amdgcn_sched_barrier(0)
    Unit cur, nxt; int ui = 0;
    if (!S.next(0, cur)) return;
    f32x4 acc[2][2][4][2];
#pragma unroll
    for (int a = 0; a < 2; ++a)
#pragma unroll
        for (int b = 0; b < 2; ++b)
#pragma unroll
            for (int m = 0; m < 4; ++m)
#pragma unroll
                for (int n = 0; n < 2; ++n) acc[a][b][m][n] = (f32x4){0.f, 0.f, 0.f, 0.f};
    bf16x8 At[4][2], B0[2][2], B1[2][2];
    const char* cA = (const char*)g.A + (size_t)cur.pm * tstep; const char* cB = (const char*)g.Bt + (size_t)cur.pn * tstep;
    S.a_ready(cur);
    if constexpr (SP2) {
        PG8_STAGE(PG8_SB(0, 0), cB, voffB); PG8_STAGE(PG8_SB(0, 1), cB + hstep, voffB); PG8_STAGE(PG8_SA(0, 0), cA, voffA); PG8_STAGE(PG8_SA(0, 1), cA + hstep, voffA);
        if (wr == 1) PG8_BAR;
        PG8_WAIT_V(2); PG8_BAR;
        PG8_STAGE(PG8_SB(1, 0), cB + kstep, voffB); PG8_STAGE(PG8_SA(1, 0), cA + kstep, voffA); PG8_STAGE(PG8_SB(1, 1), cB + hstep + kstep, voffB);
        PG8_WAIT_V(6); PG8_BAR;
    } else {
        PG8_STAGE(PG8_SB(0, 0), cB, voffB); PG8_STAGE(PG8_SA(0, 0), cA, voffA); PG8_STAGE(PG8_SB(0, 1), cB + hstep, voffB); PG8_STAGE(PG8_SA(0, 1), cA + hstep, voffA);
        if (wr == 1) PG8_BAR;
        PG8_WAIT_V(4); PG8_BAR;
        PG8_STAGE(PG8_SB(1, 0), cB + kstep, voffB); PG8_STAGE(PG8_SA(1, 0), cA + kstep, voffA); PG8_STAGE(PG8_SB(1, 1), cB + hstep + kstep, voffB);
        PG8_WAIT_V(6); PG8_BAR;
    }
    for (;;) {
        const bool has_next = S.next(ui + 1, nxt);
        const char* nA = has_next ? (const char*)g.A + (size_t)nxt.pm * tstep : cA; const char* nB = has_next ? (const char*)g.Bt + (size_t)nxt.pn * tstep : cB;
        for (int t = 0; t < nt; t += 2) {
            const bool last = (t == nt - 2);
            const char* a1 = cA + (size_t)(t + 1) * kstep;
            const char* a2 = last ? nA : cA + (size_t)(t + 2) * kstep; const char* b2 = last ? nB : cB + (size_t)(t + 2) * kstep;
            const char* a3 = a2 + kstep; const char* b3 = b2 + kstep;
            if (last && has_next) S.a_ready(nxt);
            if constexpr (SP2) {
            PG8_LDB(B0, 0, 0); PG8_LDB(B1, 0, 1); PG8_SCHED; PG8_LDA(At, 0, 0); PG8_STAGE(PG8_SA(1, 1), a1 + hstep, voffA);
            PG8_WAIT_V(8); PG8_WAIT_L(0); PG8_BAR; PG8_MMA(0, 0, At, B0); PG8_MMA(0, 1, At, B1); PG8_BAR; PG8_SCHED;
            PG8_LDA(At, 0, 1); PG8_STAGE(PG8_SB(0, 0), b2, voffB); PG8_STAGE(PG8_SB(0, 1), b2 + hstep, voffB); PG8_STAGE(PG8_SA(0, 0), a2, voffA);
            PG8_WAIT_V(8); PG8_WAIT_L(0); PG8_BAR; PG8_MMA(1, 0, At, B0); PG8_MMA(1, 1, At, B1); PG8_BAR; PG8_SCHED;
            PG8_LDB(B0, 1, 0); PG8_LDB(B1, 1, 1); PG8_SCHED; PG8_LDA(At, 1, 0); PG8_STAGE(PG8_SA(0, 1), a2 + hstep, voffA);
            PG8_WAIT_V(8); PG8_WAIT_L(0); PG8_BAR; PG8_MMA(0, 0, At, B0); PG8_MMA(0, 1, At, B1); PG8_BAR; PG8_SCHED;
            PG8_LDA(At, 1, 1); PG8_STAGE(PG8_SB(1, 0), b3, voffB); PG8_STAGE(PG8_SB(1, 1), b3 + hstep, voffB); PG8_STAGE(PG8_SA(1, 0), a3, voffA);
            PG8_WAIT_V(8); PG8_WAIT_L(0); PG8_BAR; PG8_MMA(1, 0, At, B0); PG8_MMA(1, 1, At, B1); PG8_BAR; PG8_SCHED;
            } else {
            PG8_LDB(B0, 0, 0); PG8_SCHED; PG8_LDA(At, 0, 0); PG8_STAGE(PG8_SA(1, 1), a1 + hstep, voffA);
            PG8_WAIT_L(8); PG8_BAR; PG8_WAIT_L(0); PG8_MMA(0, 0, At, B0); PG8_BAR; PG8_SCHED;
            PG8_LDB(B1, 0, 1); PG8_STAGE(PG8_SB(0, 0), b2, voffB);
            PG8_BAR; PG8_WAIT_L(0); PG8_MMA(0, 1, At, B1); PG8_BAR;
            PG8_LDA(At, 0, 1); PG8_STAGE(PG8_SA(0, 0), a2, voffA);
            PG8_BAR; PG8_WAIT_L(0); PG8_MMA(1, 0, At, B0); PG8_BAR; PG8_SCHED;
            PG8_STAGE(PG8_SB(0, 1), b2 + hstep, voffB);
            PG8_WAIT_V(6); PG8_BAR; PG8_MMA(1, 1, At, B1); PG8_BAR;
            PG8_LDB(B0, 1, 0); PG8_SCHED; PG8_LDA(At, 1, 0); PG8_STAGE(PG8_SA(0, 1), a2 + hstep, voffA);
            PG8_WAIT_L(8); PG8_BAR; PG8_WAIT_L(0); PG8_MMA(0, 0, At, B0); PG8_BAR; PG8_SCHED;
            PG8_LDB(B1, 1, 1); PG8_STAGE(PG8_SB(1, 0), b3, voffB);
            PG8_BAR; PG8_WAIT_L(0); PG8_MMA(0, 1, At, B1); PG8_BAR;
            PG8_LDA(At, 1, 1); PG8_STAGE(PG8_SA(1, 0), a3, voffA);
            PG8_BAR; PG8_WAIT_L(0); PG8_MMA(1, 0, At, B0); PG8_BAR; PG8_SCHED;
            PG8_STAGE(PG8_SB(1, 1), b3 + hstep, voffB);
            PG8_WAIT_V(6); PG8_BAR; PG8_MMA(1, 1, At, B1); PG8_BAR;
            }
        }
        if constexpr (ALIGN_EPI) { if (wr == 0) PG8_BAR; }
        if constexpr (!Epi::AFTER_DRAIN) { E(acc, cur, wr, wc, fr, fq); S.done(cur); }
        if (!has_next) break;
#pragma unroll
        for (int a = 0; a < 2; ++a)
#pragma unroll
            for (int b = 0; b < 2; ++b)
#pragma unroll
                for (int m = 0; m < 4; ++m)
#pragma unroll
                    for (int n = 0; n < 2; ++n) acc[a][b][m][n] = (f32x4){0.f, 0.f, 0.f, 0.f};
        cur = nxt; cA = nA; cB = nB; ++ui;
        if constexpr (ALIGN_EPI) { if (wr == 1) PG8_BAR; }
    }
    PG8_WAIT_V(0);
    if constexpr (!ALIGN_EPI) { if (wr == 0) PG8_BAR; }
    PG8_BAR;
    if constexpr (Epi::AFTER_DRAIN) { E.fused(acc, cur, wr, wc, fr, fq, lds, wid, lane); S.done(cur); }
#undef PG8_SA
#undef PG8_SB
#undef PG8_STAGE
#undef PG8_LDA
#undef PG8_LDB
#undef PG8_MMA
#undef PG8_WAIT_V
#undef PG8_WAIT_L
#undef PG8_BAR
#undef PG8_SCHED
}
}

#define LAS __attribute__((address_space(3)))
#define DI __device__ __forceinline__
typedef unsigned short bf16;
typedef short bf16x8 __attribute__((ext_vector_type(8)));
typedef short s16x4 __attribute__((ext_vector_type(4)));
typedef float f32x4 __attribute__((ext_vector_type(4)));
typedef float f32x16 __attribute__((ext_vector_type(16)));
typedef unsigned u32x4 __attribute__((ext_vector_type(4)));
typedef unsigned u32x2 __attribute__((ext_vector_type(2)));
#define MFMA32(a, b, c) __builtin_amdgcn_mfma_f32_32x32x16_bf16((a), (b), (c), 0, 0, 0)
using pg8::pk2; using pg8::f2bf1;
DI float bf2f(unsigned v) { return __uint_as_float(v << 16); }
DI int crow(int i, int h) { return (i & 3) + 8 * (i >> 2) + 4 * h; }

__device__ const float INV_FREQ[32] = {1.000000000e+00f, 7.498942614e-01f, 5.623413324e-01f, 4.216965139e-01f, 3.162277639e-01f, 2.371373773e-01f, 1.778279394e-01f, 1.333521307e-01f,
    1.000000015e-01f, 7.498941571e-02f, 5.623413250e-02f, 4.216965288e-02f, 3.162277490e-02f, 2.371373773e-02f, 1.778279431e-02f, 1.333521493e-02f,
    9.999999776e-03f, 7.498941850e-03f, 5.623413250e-03f, 4.216964822e-03f, 3.162277630e-03f, 2.371373586e-03f, 1.778279431e-03f, 1.333521446e-03f,
    1.000000047e-03f, 7.498942432e-04f, 5.623413017e-04f, 4.216965172e-04f, 3.162277571e-04f, 2.371373703e-04f, 1.778279402e-04f, 1.333521504e-04f};

struct Args { const void* in[23]; float* out; unsigned char* ws; int ph_lo, ph_hi; };

DI int opaque_tid() { int t = threadIdx.x; asm volatile("" : "+v"(t)); return t; }
DI int opaque_bid() { int b = blockIdx.x; asm volatile("" : "+s"(b)); return b; }
DI float wave_sum(float v) {
#pragma unroll
    for (int o = 1; o < 64; o <<= 1) v += __shfl_xor(v, o);
    return v;
}

DI int rowmap(int mode, int n) {
    if (mode == 1) {
        if (n < 256) return n;
        if (n < 512) { const int q = n - 256, g = q >> 6, dd = q & 63; return 256 + 128 * (dd >> 5) + 32 * g + (dd & 31); }
        if (n < 768) return n;
        if (n < 1408) { const int base = n & ~63, d = n & 63; return base + 8 * ((d & 31) >> 2) + 4 * (d >> 5) + (d & 3); }
        return n;
    }
    if (mode == 2) {
        if (n < D_FF) return 8 * (n >> 2) + (n & 3);
        const int q = n - D_FF; return 8 * (q >> 2) + 4 + (q & 3);
    }
    return n;
}
DI void transpose_item(const float* W, int K, int N, bf16* WT, int mode, const float* gain, LAS float* scr, int item, int lane) {
    const int nblk = N / 32, kb = item / nblk, nbk = item % nblk, k0 = 64 * kb, n0 = 32 * nbk;
#pragma unroll 8
    for (int i = 0; i < 32; ++i) { const int kk = 2 * i + (lane >> 5); float v = W[(size_t)(k0 + kk) * N + n0 + (lane & 31)]; if (gain) v *= gain[k0 + kk]; scr[kk * 33 + (lane & 31)] = v; }
    asm volatile("s_waitcnt lgkmcnt(0)" ::: "memory"); __builtin_amdgcn_wave_barrier();
    const int c = lane & 7;
#pragma unroll
    for (int j = 0; j < 4; ++j) { const int n = (lane >> 3) + 8 * j; const LAS float* s = scr + (8 * c) * 33 + n;
        u32x4 o; o.x = pk2(s[0 * 33], s[1 * 33]); o.y = pk2(s[2 * 33], s[3 * 33]); o.z = pk2(s[4 * 33], s[5 * 33]); o.w = pk2(s[6 * 33], s[7 * 33]);
        *(u32x4*)(WT + (size_t)rowmap(mode, n0 + n) * K + k0 + 8 * c) = o; }
    asm volatile("s_waitcnt lgkmcnt(0)" ::: "memory"); __builtin_amdgcn_wave_barrier();
}

DI void prologue(const Args& a, LAS unsigned char* lds, int G) {
    unsigned char* ws = a.ws;
    const int tid = threadIdx.x, lane = tid & 63, wave = tid >> 6;
    const int gw = blockIdx.x * NWAVES + wave, NGW = G * NWAVES;
    const int gt = blockIdx.x * NTHREADS + tid, NGT = G * NTHREADS;
    LAS float* scr = (LAS float*)(lds + wave * 16384);
    constexpr int I_IN = 16 * 48, I_O = 16 * 32, I_GU = 16 * 176, I_DN = 44 * 32, I_KV = 16 * 64;
    constexpr int PER_L = I_IN + 3 * I_O + I_GU + I_DN + I_KV;
    for (int it = gw; it < DEPTH * PER_L; it += NGW) {
        const int l = it / PER_L; int r = it % PER_L;
        if (r < I_IN) { transpose_item(((const float*)a.in[6]) + (size_t)l * DM * D_IN, DM, D_IN, (bf16*)(ws + WS_WIN) + (size_t)l * D_IN * DM, 1, ((const float*)a.in[4]) + l * DM, scr, r, lane); continue; } r -= I_IN;
        if (r < I_O) { transpose_item(((const float*)a.in[13]) + (size_t)l * DM * DM, DM, DM, (bf16*)(ws + WS_WO) + (size_t)l * DM * DM, 0, nullptr, scr, r, lane); continue; } r -= I_O;
        if (r < I_O) { transpose_item(((const float*)a.in[16]) + (size_t)l * DM * DM, DM, DM, (bf16*)(ws + WS_WXQ) + (size_t)l * DM * DM, 0, ((const float*)a.in[14]) + l * DM, scr, r, lane); continue; } r -= I_O;
        if (r < I_O) { transpose_item(((const float*)a.in[18]) + (size_t)l * DM * DM, DM, DM, (bf16*)(ws + WS_WXO) + (size_t)l * DM * DM, 0, nullptr, scr, r, lane); continue; } r -= I_O;
        if (r < I_GU) { transpose_item(((const float*)a.in[21]) + (size_t)l * DM * 2 * D_FF, DM, 2 * D_FF, (bf16*)(ws + WS_WGU) + (size_t)l * 2 * D_FF * DM, 2, ((const float*)a.in[19]) + l * DM, scr, r, lane); continue; } r -= I_GU;
        if (r < I_DN) { transpose_item(((const float*)a.in[22]) + (size_t)l * D_FF * DM, D_FF, DM, (bf16*)(ws + WS_WDN) + (size_t)l * DM * D_FF, 0, nullptr, scr, r, lane); continue; } r -= I_DN;
        transpose_item(((const float*)a.in[17]) + (size_t)l * DM * 2 * DM, DM, 2 * DM, (bf16*)(ws + WS_WXKV) + (size_t)l * 2 * DM * DM, 0, nullptr, scr, r, lane);
    }
    { bf16* WMk = (bf16*)(ws + WS_WM);
      for (int i = gt; i < DEPTH * 4 * 128 * 128; i += NGT) { const int s = i & 127, t = (i >> 7) & 127; WMk[i] = (s <= t) ? f2bf1(((const float*)a.in[8])[i]) : (bf16)0; }
      bf16* PWT = (bf16*)(ws + WS_PWT);
      for (int i = gt; i < DEPTH * 4 * 64 * 64; i += NGT) { const int c = i & 63, d = (i >> 6) & 63, lg = i >> 12; PWT[i] = f2bf1(((const float*)a.in[10])[(size_t)lg * 4096 + c * 64 + d]); }
      float* par = (float*)(ws + WS_PAR);
      for (int i = gt; i < 1024; i += NGT) par[PAR_VG + i] = ((const float*)a.in[7])[i];
      for (int i = gt; i < 2048; i += NGT) par[PAR_BS + i] = ((const float*)a.in[9])[i];
      for (int i = gt; i < 1024; i += NGT) par[PAR_PSC + i] = ((const float*)a.in[11])[i];
      for (int i = gt; i < 32; i += NGT) par[PAR_SNK + i] = ((const float*)a.in[12])[i];
      for (int i = gt; i < DEPTH * 3 * DM; i += NGT) { const int l = i / (3 * DM), k = (i / DM) % 3, c = i % DM; par[PAR_GPOST + i] = ((const float*)a.in[k == 0 ? 5 : (k == 1 ? 15 : 20)])[l * DM + c]; }
      float* cosT = (float*)(ws + WS_COS); float* sinT = (float*)(ws + WS_SIN);
      for (int i = gt; i < M * 32; i += NGT) {
          const int r = i >> 5, k = i & 31;
          const float ang = (float)((const int*)a.in[2])[r] * INV_FREQ[k];
          const double ad = (double)ang;
          const double q = __builtin_rint(ad * 0.63661977236758134308);
          double rr = __builtin_fma(-q, 1.57079632679489655800e+00, ad); rr = __builtin_fma(-q, 6.12323399573676603587e-17, rr);
          const double x2 = rr * rr;
          double sp = -1.0 / 6227020800.0; sp = sp * x2 + 1.0 / 39916800.0; sp = sp * x2 - 1.0 / 362880.0; sp = sp * x2 + 1.0 / 5040.0; sp = sp * x2 - 1.0 / 120.0; sp = sp * x2 + 1.0 / 6.0; sp = rr - rr * x2 * sp;
          double cp = 1.0 / 87178291200.0; cp = cp * x2 - 1.0 / 479001600.0; cp = cp * x2 + 1.0 / 3628800.0; cp = cp * x2 - 1.0 / 40320.0; cp = cp * x2 + 1.0 / 720.0; cp = cp * x2 - 1.0 / 24.0; cp = cp * x2 + 0.5; cp = 1.0 - x2 * cp;
          const int qi = ((int)q) & 3;
          const double sv = (qi == 0) ? sp : (qi == 1) ? cp : (qi == 2) ? -sp : -cp;
          const double cv = (qi == 0) ? cp : (qi == 1) ? -sp : (qi == 2) ? -cp : sp;
          cosT[i] = (float)cv; sinT[i] = (float)sv;
      }
    }
    { bf16* XB = (bf16*)(ws + WS_XB); float* rsx = (float*)(ws + WS_RS);
      for (int r = gw; r < M; r += NGW) {
          const f32x4* xr = (const f32x4*)(((const float*)a.in[0]) + (size_t)r * DM) + lane; float ss = 0.f;
#pragma unroll
          for (int j = 0; j < 4; ++j) { const f32x4 v = xr[64 * j]; ss += (v[0] * v[0] + v[1] * v[1]) + (v[2] * v[2] + v[3] * v[3]);
              u32x2 w; w.x = pk2(v[0], v[1]); w.y = pk2(v[2], v[3]); *((u32x2*)(XB + (size_t)r * DM) + lane + 64 * j) = w; }
          ss = wave_sum(ss); if (lane == 0) rsx[r] = rsqrtf(ss * (1.f / DM) + EPS);
      }
      bf16* MN = (bf16*)(ws + WS_MEMN);
      for (int r = gw; r < MMEM; r += NGW) {
          const f32x4* xr = (const f32x4*)(((const float*)a.in[1]) + (size_t)r * DM) + lane; f32x4 v[4]; float ss = 0.f;
#pragma unroll
          for (int j = 0; j < 4; ++j) { v[j] = xr[64 * j]; ss += (v[j][0] * v[j][0] + v[j][1] * v[j][1]) + (v[j][2] * v[j][2] + v[j][3] * v[j][3]); }
          ss = wave_sum(ss); const float rn = rsqrtf(ss * (1.f / DM) + EPS);
#pragma unroll
          for (int j = 0; j < 4; ++j) { const f32x4 g = *((const f32x4*)((const float*)a.in[3]) + lane + 64 * j); const f32x4 o = v[j] * rn * g;
              u32x2 w; w.x = pk2(o[0], o[1]); w.y = pk2(o[2], o[3]); *((u32x2*)(MN + (size_t)r * DM) + lane + 64 * j) = w; }
      }
    }
}

DI void res_phase(float* out_final, unsigned char* ws, int gidx, int G) {
    const bf16* Y = (const bf16*)(ws + WS_Y); const float* ysq = (const float*)(ws + WS_YSQ); const float* gpost = (const float*)(ws + WS_PAR) + PAR_GPOST + gidx * DM; bf16* XB = (bf16*)(ws + WS_XB); float* rsx = (float*)(ws + WS_RS);
    const int tid = opaque_tid(), lane = tid & 63, wave = tid >> 6;
    const int gw = opaque_bid() * NWAVES + wave, NGW = G * NWAVES;
    f32x4 g4[4];
#pragma unroll
    for (int j = 0; j < 4; ++j) g4[j] = *((const f32x4*)gpost + lane + 64 * j);
    for (int r = gw; r < M; r += NGW) {
        float ysum = 0.f;
#pragma unroll
        for (int j = 0; j < 4; ++j) { const f32x4 q = *((const f32x4*)(ysq + (size_t)r * 16) + j); ysum += (q[0] + q[1]) + (q[2] + q[3]); }
        const float rn = rsqrtf(ysum * (1.f / DM) + EPS);
        float ss = 0.f;
#pragma unroll
        for (int j = 0; j < 4; ++j) {
            const u32x2 xw = *((const u32x2*)(XB + (size_t)r * DM) + lane + 64 * j);
            const u32x2 yw = *((const u32x2*)(Y + (size_t)r * DM) + lane + 64 * j);
            f32x4 xv; xv[0] = bf2f(xw.x & 0xffffu); xv[1] = bf2f(xw.x >> 16); xv[2] = bf2f(xw.y & 0xffffu); xv[3] = bf2f(xw.y >> 16);
            f32x4 yv; yv[0] = bf2f(yw.x & 0xffffu); yv[1] = bf2f(yw.x >> 16); yv[2] = bf2f(yw.y & 0xffffu); yv[3] = bf2f(yw.y >> 16);
            const f32x4 xn = xv + yv * rn * g4[j];
            if (out_final) *((f32x4*)(out_final + (size_t)r * DM) + lane + 64 * j) = xn;
            else { ss += (xn[0] * xn[0] + xn[1] * xn[1]) + (xn[2] * xn[2] + xn[3] * xn[3]);
                u32x2 w; w.x = pk2(xn[0], xn[1]); w.y = pk2(xn[2], xn[3]); *((u32x2*)(XB + (size_t)r * DM) + lane + 64 * j) = w; }
        }
        if (!out_final) { ss = wave_sum(ss); if (lane == 0) rsx[r] = rsqrtf(ss * (1.f / DM) + EPS); }
    }
}

DI void mixer_phase(unsigned char* ws, int l, LAS unsigned char* lds, int G) {
    const bf16* U = (const bf16*)(ws + WS_U); const bf16* VNT = (const bf16*)(ws + WS_VNT); const bf16* P = (const bf16*)(ws + WS_P);
    const bf16* Q = (const bf16*)(ws + WS_Q); const bf16* Kb = (const bf16*)(ws + WS_K); const bf16* VT = (const bf16*)(ws + WS_VT);
    bf16* MIX = (bf16*)(ws + WS_BUFA);
    const bf16* WMk = (const bf16*)(ws + WS_WM) + (size_t)l * 4 * 128 * 128; const bf16* PWT = (const bf16*)(ws + WS_PWT) + (size_t)l * 4 * 64 * 64;
    const float* par = (const float*)(ws + WS_PAR); const float* bs = par + PAR_BS + l * 512; const float* pscale = par + PAR_PSC + l * 256; const float* sinks = par + PAR_SNK + l * 8;
    const int tid = opaque_tid(), lane = tid & 63, wave = __builtin_amdgcn_readfirstlane(tid >> 6), c32 = lane & 31, h = lane >> 5;
    LAS unsigned char* Ks = lds; LAS unsigned char* Vs = lds + 36864;
    for (int blk = opaque_bid(); blk < M / 128; blk += G) {
        const int row0 = blk * 128, b = blk >> 5, nb = blk & 31;
        const int tt = wave >> 1, dtile = wave & 1;
#pragma unroll 1
        for (int g = 0; g < 4; ++g) {
            f32x16 acc;
#pragma unroll
            for (int i = 0; i < 16; ++i) acc[i] = 0.f;
            const bf16* Wrow = WMk + ((size_t)(g * 128 + 32 * tt + c32)) * 128 + 8 * h;
            const bf16* Vrow = VNT + ((size_t)(blk * 4 + g) * 64 + 32 * dtile + c32) * 128 + 8 * h;
            for (int ks = 0; ks <= 2 * tt + 1; ++ks) { const bf16x8 af = *(const bf16x8*)(Wrow + 16 * ks); const bf16x8 bfr = *(const bf16x8*)(Vrow + 16 * ks); acc = MFMA32(af, bfr, acc); }
            const int d = g * 64 + 32 * dtile + c32;
#pragma unroll
            for (int i = 0; i < 16; ++i) { const int t = 32 * tt + crow(i, h); const size_t r = (size_t)(row0 + t);
                const float mixed = acc[i] + bs[g * 128 + t]; const float uu = bf2f(U[r * 256 + d]);
                MIX[r * 1024 + d] = f2bf1(uu * mixed); }
        }
#pragma unroll 1
        for (int g = 0; g < 4; ++g) {
            const int w = 2 << g;
            f32x16 acc;
#pragma unroll
            for (int i = 0; i < 16; ++i) acc[i] = 0.f;
            const int t = 32 * tt + c32, tpos = nb * 128 + t; const int cnt = (tpos + 1 < w) ? (tpos + 1) : w; const float icnt = 1.f / (float)cnt;
#pragma unroll 1
            for (int ks = 0; ks < 4; ++ks) {
                const bf16* prow = P + (size_t)(row0 + t) * 256 + g * 64 + 16 * ks + 8 * h;
                float sum[8], own[8];
#pragma unroll
                for (int e = 0; e < 8; ++e) sum[e] = 0.f;
                for (int k = 0; k < cnt; ++k) { const u32x4 v = *(const u32x4*)(prow - (size_t)k * 256);
                    float f[8]; f[0] = bf2f(v.x & 0xffffu); f[1] = bf2f(v.x >> 16); f[2] = bf2f(v.y & 0xffffu); f[3] = bf2f(v.y >> 16); f[4] = bf2f(v.z & 0xffffu); f[5] = bf2f(v.z >> 16); f[6] = bf2f(v.w & 0xffffu); f[7] = bf2f(v.w >> 16);
#pragma unroll
                    for (int e = 0; e < 8; ++e) { sum[e] += f[e]; if (k == 0) own[e] = f[e]; } }
                u32x4 pa; pa.x = pk2(sum[0] * icnt - own[0], sum[1] * icnt - own[1]); pa.y = pk2(sum[2] * icnt - own[2], sum[3] * icnt - own[3]);
                pa.z = pk2(sum[4] * icnt - own[4], sum[5] * icnt - own[5]); pa.w = pk2(sum[6] * icnt - own[6], sum[7] * icnt - own[7]);
                const bf16x8 af = __builtin_bit_cast(bf16x8, pa);
                const bf16x8 bfr = *(const bf16x8*)(PWT + ((size_t)(g * 64 + 32 * dtile + c32)) * 64 + 16 * ks + 8 * h);
                acc = MFMA32(af, bfr, acc);
            }
            const int d = g * 64 + 32 * dtile + c32; const float psc = pscale[d];
#pragma unroll
            for (int i = 0; i < 16; ++i) { const size_t r = (size_t)(row0 + 32 * tt + crow(i, h)); MIX[r * 1024 + 256 + d] = f2bf1(acc[i] * psc); }
        }
#pragma unroll 1
        for (int hv = 0; hv < 2; ++hv) {
            __syncthreads();
#pragma unroll
            for (int it = 0; it < 4; ++it) { const int id = tid + NTHREADS * it;
                { const int kk = id >> 3, ch = id & 7; u32x4 v = {0u, 0u, 0u, 0u};
                  if (nb > 0 || kk >= 128) v = *(const u32x4*)(Kb + (size_t)(row0 - 128 + kk) * 128 + hv * 64 + ch * 8);
                  *(LAS u32x4*)(Ks + kk * 144 + ch * 16) = v; }
                { const int d = id >> 5, ch = id & 31; u32x4 v = {0u, 0u, 0u, 0u};
                  if (nb > 0 || ch >= 16) v = *(const u32x4*)(VT + ((size_t)((b * 2 + hv) * 32 + nb - 1 + (ch >> 4)) * 64 + d) * 128 + (ch & 15) * 8);
                  *(LAS u32x4*)(Vs + d * 528 + ch * 16) = v; } }
            __syncthreads();
#pragma unroll 1
            for (int it = 0; it < 2; ++it) {
                const int qh = wave & 3, sb = (wave >> 2) + 2 * it, head = 4 * hv + qh;
                const size_t r = (size_t)(row0 + 32 * sb + c32);
                bf16x8 qf[4];
#pragma unroll
                for (int st = 0; st < 4; ++st) qf[st] = *(const bf16x8*)(Q + r * 512 + head * 64 + 16 * st + 8 * h);
                f32x16 S[5];
#pragma unroll
                for (int kt = 0; kt < 5; ++kt) {
#pragma unroll
                    for (int i = 0; i < 16; ++i) S[kt][i] = 0.f;
#pragma unroll
                    for (int st = 0; st < 4; ++st) { const bf16x8 kf = *(const LAS bf16x8*)(Ks + (32 * (sb + kt) + c32) * 144 + (16 * st + 8 * h) * 2); S[kt] = MFMA32(kf, qf[st], S[kt]); }
                }
                const float sink = sinks[head] * LOG2E;
                float mx = sink;
#pragma unroll
                for (int kt = 0; kt < 5; ++kt)
#pragma unroll
                    for (int i = 0; i < 16; ++i) { const int krel = 32 * kt + crow(i, h);
                        const bool valid = (krel > c32) && (krel <= c32 + 128) && (nb > 0 || 32 * sb + krel >= 128);
                        const float sv = valid ? S[kt][i] : -INFINITY; S[kt][i] = sv; mx = fmaxf(mx, sv); }
                mx = fmaxf(mx, __shfl_xor(mx, 32));
                float sum = 0.f;
#pragma unroll
                for (int kt = 0; kt < 5; ++kt)
#pragma unroll
                    for (int i = 0; i < 16; ++i) { const float e = __builtin_amdgcn_exp2f(S[kt][i] - mx); S[kt][i] = e; sum += e; }
                sum += __shfl_xor(sum, 32); sum += __builtin_amdgcn_exp2f(sink - mx);
                const float inv = 1.f / sum;
                f32x16 O[2];
#pragma unroll
                for (int i = 0; i < 16; ++i) { O[0][i] = 0.f; O[1][i] = 0.f; }
#pragma unroll
                for (int kt = 0; kt < 5; ++kt)
#pragma unroll
                    for (int s = 0; s < 2; ++s) {
                        u32x4 pw; pw.x = pk2(S[kt][8 * s + 0], S[kt][8 * s + 1]); pw.y = pk2(S[kt][8 * s + 2], S[kt][8 * s + 3]); pw.z = pk2(S[kt][8 * s + 4], S[kt][8 * s + 5]); pw.w = pk2(S[kt][8 * s + 6], S[kt][8 * s + 7]);
                        const bf16x8 pf = __builtin_bit_cast(bf16x8, pw);
#pragma unroll
                        for (int dt = 0; dt < 2; ++dt) { const LAS unsigned char* vp = Vs + (32 * dt + c32) * 528 + (32 * (sb + kt) + 16 * s + 4 * h) * 2;
                            const u32x2 lo = *(const LAS u32x2*)vp, hi = *(const LAS u32x2*)(vp + 16);
                            u32x4 vv; vv.x = lo.x; vv.y = lo.y; vv.z = hi.x; vv.w = hi.y;
                            O[dt] = MFMA32(__builtin_bit_cast(bf16x8, vv), pf, O[dt]); }
                    }
#pragma unroll
                for (int dt = 0; dt < 2; ++dt)
#pragma unroll
                    for (int g4 = 0; g4 < 4; ++g4) { u32x2 w; w.x = pk2(O[dt][4 * g4] * inv, O[dt][4 * g4 + 1] * inv); w.y = pk2(O[dt][4 * g4 + 2] * inv, O[dt][4 * g4 + 3] * inv);
                        *(u32x2*)(MIX + r * 1024 + 512 + head * 64 + 32 * dt + 8 * g4 + 4 * h) = w; }
            }
        }
        __syncthreads();
    }
}

DI void xattn_phase(unsigned char* ws, int l, LAS unsigned char* lds, int G) {
    bf16* QX = (bf16*)(ws + WS_BUFA);
    const bf16* KM = (const bf16*)(ws + WS_KM) + (size_t)l * MMEM * DM; const bf16* VTM = (const bf16*)(ws + WS_VTM) + (size_t)l * MMEM * DM;
    const int tid = opaque_tid(), lane = tid & 63, wave = __builtin_amdgcn_readfirstlane(tid >> 6), c32 = lane & 31, h = lane >> 5;
    for (int item = opaque_bid(); item < NBATCH * 4 * 16; item += G) {
        const int qc = item & 15, head = (item >> 4) & 3, b = item >> 6;
        __syncthreads();
#pragma unroll 4
        for (int it = 0; it < 16; ++it) { const int id = tid + NTHREADS * it, mrow = id >> 5, ch = id & 31;
            *(LAS u32x4*)(lds + mrow * 528 + ch * 16) = *(const u32x4*)(KM + (size_t)(b * 256 + mrow) * 1024 + head * 256 + ch * 8); }
        __syncthreads();
        const size_t r = (size_t)b * SEQ + qc * 256 + 32 * wave + c32;
        f32x16 S[8];
#pragma unroll
        for (int mt = 0; mt < 8; ++mt)
#pragma unroll
            for (int i = 0; i < 16; ++i) S[mt][i] = 0.f;
#pragma unroll 2
        for (int st = 0; st < 16; ++st) { const bf16x8 qf = *(const bf16x8*)(QX + r * 1024 + head * 256 + 16 * st + 8 * h);
#pragma unroll
            for (int mt = 0; mt < 8; ++mt) { const bf16x8 kf = *(const LAS bf16x8*)(lds + (32 * mt + c32) * 528 + (16 * st + 8 * h) * 2); S[mt] = MFMA32(kf, qf, S[mt]); } }
        float mx = -INFINITY;
#pragma unroll
        for (int mt = 0; mt < 8; ++mt)
#pragma unroll
            for (int i = 0; i < 16; ++i) mx = fmaxf(mx, S[mt][i]);
        mx = fmaxf(mx, __shfl_xor(mx, 32));
        float sum = 0.f; bf16x8 pf[8][2];
#pragma unroll
        for (int mt = 0; mt < 8; ++mt) {
#pragma unroll
            for (int i = 0; i < 16; ++i) { const float e = __builtin_amdgcn_exp2f(S[mt][i] - mx); S[mt][i] = e; sum += e; }
#pragma unroll
            for (int s = 0; s < 2; ++s) { u32x4 pw; pw.x = pk2(S[mt][8 * s + 0], S[mt][8 * s + 1]); pw.y = pk2(S[mt][8 * s + 2], S[mt][8 * s + 3]); pw.z = pk2(S[mt][8 * s + 4], S[mt][8 * s + 5]); pw.w = pk2(S[mt][8 * s + 6], S[mt][8 * s + 7]);
                pf[mt][s] = __builtin_bit_cast(bf16x8, pw); }
        }
        sum += __shfl_xor(sum, 32);
        const float inv = 1.f / sum;
        __syncthreads();
#pragma unroll 4
        for (int it = 0; it < 16; ++it) { const int id = tid + NTHREADS * it, d = id >> 5, ch = id & 31;
            *(LAS u32x4*)(lds + d * 528 + ch * 16) = *(const u32x4*)(VTM + ((size_t)(b * 4 + head) * 256 + d) * 256 + ch * 8); }
        __syncthreads();
#pragma unroll 1
        for (int dt = 0; dt < 8; ++dt) {
            f32x16 O;
#pragma unroll
            for (int i = 0; i < 16; ++i) O[i] = 0.f;
#pragma unroll
            for (int mt = 0; mt < 8; ++mt)
#pragma unroll
                for (int s = 0; s < 2; ++s) { const LAS unsigned char* vp = lds + (32 * dt + c32) * 528 + (32 * mt + 16 * s + 4 * h) * 2;
                    const u32x2 lo = *(const LAS u32x2*)vp, hi = *(const LAS u32x2*)(vp + 16);
                    u32x4 vv; vv.x = lo.x; vv.y = lo.y; vv.z = hi.x; vv.w = hi.y;
                    O = MFMA32(__builtin_bit_cast(bf16x8, vv), pf[mt][s], O); }
#pragma unroll
            for (int g4 = 0; g4 < 4; ++g4) { u32x2 w; w.x = pk2(O[4 * g4] * inv, O[4 * g4 + 1] * inv); w.y = pk2(O[4 * g4 + 2] * inv, O[4 * g4 + 3] * inv);
                *(u32x2*)(QX + r * 1024 + head * 256 + 32 * dt + 8 * g4 + 4 * h) = w; }
        }
    }
    __syncthreads();
}

#define XB_TMO      128
#define XB_XCNT(j)  (256  + 64 * (j))
#define XB_XSUB(j)  (1280 + 64 * (j))
#define XB_XGEN(j)  (2304 + 64 * (j))
#define XB_TOP      3328
#define XB_TOPGEN   3392
#define XCD_BAR_WORDS 3456
#define XB_SPIN_CAP (1u << 18)

__device__ __forceinline__ unsigned xb_ld(unsigned* p)              { return __hip_atomic_load(p, __ATOMIC_RELAXED, __HIP_MEMORY_SCOPE_AGENT); }
__device__ __forceinline__ unsigned xb_add(unsigned* p, unsigned v) { return __hip_atomic_fetch_add(p, v, __ATOMIC_RELAXED, __HIP_MEMORY_SCOPE_AGENT); }
__device__ __forceinline__ unsigned xb_xcc_id() { return (unsigned)__builtin_amdgcn_s_getreg((3 << 11) | 20) & 0xFu; }
#define XB_SPIN(cond, bar) do { unsigned _sp = 0; while (cond) { __builtin_amdgcn_s_sleep(1); \
    if ((++_sp & 255u) == 0u) { if (xb_ld(&(bar)[XB_TMO])) break; if (_sp > XB_SPIN_CAP) { atomicAdd(&(bar)[XB_TMO], 1u); break; } } } } while (0)

struct XcdBarrier {
    unsigned* bar; unsigned x;
    volatile LAS unsigned* st;
};

__device__ __forceinline__ XcdBarrier xcd_barrier_post(unsigned* bar, volatile LAS unsigned* st) {
    XcdBarrier b; b.bar = bar; b.x = xb_xcc_id(); b.st = st;
    if (threadIdx.x == 0) (void)xb_add(&bar[XB_XCNT(b.x)], 1u);
    return b;
}
__device__ __forceinline__ void xcd_barrier_complete(unsigned* bar, unsigned x, unsigned& nloc, unsigned& nx) {
    const unsigned G = gridDim.x * gridDim.y * gridDim.z;
    unsigned sum, cnt, mine, sp = 0u;
    for (;;) {
        sum = 0u; cnt = 0u; mine = 0u;
#pragma unroll
        for (unsigned j = 0; j < 16; ++j) { const unsigned c = xb_ld(&bar[XB_XCNT(j)]); sum += c; cnt += (c > 0u) ? 1u : 0u; mine = (j == x) ? c : mine; }
        if (sum == G) break;
        __builtin_amdgcn_s_sleep(1);
        if ((++sp & 255u) == 0u) { if (xb_ld(&bar[XB_TMO])) break; if (sp > XB_SPIN_CAP) { atomicAdd(&bar[XB_TMO], 1u); break; } }
    }
    nloc = mine > 0u ? mine : 1u; nx = cnt > 0u ? cnt : 1u;
}

__device__ __forceinline__ void xcd_barrier(const XcdBarrier& b) {
    asm volatile("s_waitcnt vmcnt(0)" ::: "memory");
    __syncthreads();
    if (threadIdx.x == 0) {
        unsigned* bar = b.bar;
        __builtin_amdgcn_s_waitcnt(0);
        unsigned nloc = b.st[0], nx = b.st[1];
        if (nloc == 0u) { xcd_barrier_complete(bar, b.x, nloc, nx); b.st[0] = nloc; b.st[1] = nx; }
        const unsigned old = xb_add(&bar[XB_XSUB(b.x)], 1u);
        const unsigned gen = old / nloc;
        if (old + 1u == (gen + 1u) * nloc) {
            __builtin_amdgcn_fence(__ATOMIC_RELEASE, "agent");
            asm volatile("s_waitcnt vmcnt(0)" ::: "memory");
            const unsigned og = xb_add(&bar[XB_TOP], 1u);
            const unsigned tg = og / nx;
            if (og + 1u == (tg + 1u) * nx) xb_add(&bar[XB_TOPGEN], 1u);
            else XB_SPIN(xb_ld(&bar[XB_TOPGEN]) == tg, bar);
            __builtin_amdgcn_fence(__ATOMIC_ACQUIRE, "agent");
            xb_add(&bar[XB_XGEN(b.x)], 1u);
            asm volatile("s_waitcnt vmcnt(0)" ::: "memory");
        } else {
            XB_SPIN(xb_ld(&bar[XB_XGEN(b.x)]) == gen, bar);
            __builtin_amdgcn_fence(__ATOMIC_ACQUIRE, "agent");
            asm volatile("s_waitcnt vmcnt(0)" ::: "memory");
        }
    }
    __syncthreads();
}

#ifndef PG8_SP2
#define PG8_SP2 true
#endif
#ifndef PG8_ALIGN
#define PG8_ALIGN true
#endif
constexpr int N_PHASES = 2 + 11 * DEPTH;

__global__ void __launch_bounds__(NTHREADS, 2) mk_fwd(Args a) {
    extern __shared__ __attribute__((aligned(16))) unsigned char lds_raw[];
    LAS unsigned char* lds = (LAS unsigned char*)lds_raw;
    cg::grid_group grid = cg::this_grid();
    const int G = gridDim.x, lo = a.ph_lo, hi = a.ph_hi;
    unsigned char* ws = a.ws;
    volatile LAS unsigned* bst = (volatile LAS unsigned*)(lds + LDS_BYTES - 64);
    unsigned* barw = (unsigned*)(ws + WS_BAR);
    XcdBarrier bar; bar.bar = barw; bar.x = 0; bar.st = bst;
    if (hi - lo > 1) {
        if (threadIdx.x < 2) bst[threadIdx.x] = 0u;
        if (blockIdx.x == 0) for (int i = threadIdx.x; i < XCD_BAR_WORDS; i += NTHREADS) __hip_atomic_store(barw + i, 0u, __ATOMIC_RELAXED, __HIP_MEMORY_SCOPE_AGENT);
        grid.sync();
        bar = xcd_barrier_post(barw, bst);
    }
#define IN(k) (lo <= (k) && (k) < hi)
#define SEAM(k) do { if (IN((k) + 1)) xcd_barrier(bar); } while (0)
    if (IN(0)) { prologue(a, lds, G); SEAM(0); }
    if (IN(1)) {
        pg8::Gemm g{(const pg8::bf16_t*)(ws + WS_MEMN), (const pg8::bf16_t*)(ws + WS_WXKV), MMEM, DEPTH * 2 * DM, DM}; pg8::StaticOrder S; S.init(MMEM, DEPTH * 2 * DM, G, opaque_bid());
        pg8::EpiKV E{ws};
        pg8::gemm_phase<pg8::EpiKV, pg8::StaticOrder, false, PG8_SP2>(lds, g, S, E);
        SEAM(1);
    }
#pragma unroll 1
    for (int l = 0; l < DEPTH; ++l) {
        const int p0 = 2 + 11 * l;
        if (IN(p0 + 0)) {
            pg8::Gemm g{(const pg8::bf16_t*)(ws + WS_XB), (const pg8::bf16_t*)(ws + WS_WIN) + (size_t)l * D_IN * DM, M, D_IN, DM}; pg8::StaticOrder S; S.init(M, D_IN, G, opaque_bid());
            pg8::EpiIn E{ws, l};
            pg8::gemm_phase<pg8::EpiIn, pg8::StaticOrder, PG8_ALIGN, PG8_SP2>(lds, g, S, E);
            SEAM(p0 + 0);
        }
        if (IN(p0 + 1)) { mixer_phase(ws, l, lds, G); SEAM(p0 + 1); }
        if (IN(p0 + 2)) {
            pg8::Gemm g{(const pg8::bf16_t*)(ws + WS_BUFA), (const pg8::bf16_t*)(ws + WS_WO) + (size_t)l * DM * DM, M, DM, DM}; pg8::StaticOrder S; S.init(M, DM, G, opaque_bid());
            pg8::EpiY E{ws};
            pg8::gemm_phase<pg8::EpiY, pg8::StaticOrder, PG8_ALIGN, PG8_SP2>(lds, g, S, E);
            SEAM(p0 + 2);
        }
        if (IN(p0 + 3)) { res_phase(nullptr, ws, l * 3 + 0, G); SEAM(p0 + 3); }
        if (IN(p0 + 4)) {
            pg8::Gemm g{(const pg8::bf16_t*)(ws + WS_XB), (const pg8::bf16_t*)(ws + WS_WXQ) + (size_t)l * DM * DM, M, DM, DM}; pg8::StaticOrder S; S.init(M, DM, G, opaque_bid());
            pg8::EpiQx E{ws};
            pg8::gemm_phase<pg8::EpiQx, pg8::StaticOrder, PG8_ALIGN, PG8_SP2>(lds, g, S, E);
            SEAM(p0 + 4);
        }
        if (IN(p0 + 5)) { xattn_phase(ws, l, lds, G); SEAM(p0 + 5); }
        if (IN(p0 + 6)) {
            pg8::Gemm g{(const pg8::bf16_t*)(ws + WS_BUFA), (const pg8::bf16_t*)(ws + WS_WXO) + (size_t)l * DM * DM, M, DM, DM}; pg8::StaticOrder S; S.init(M, DM, G, opaque_bid());
            pg8::EpiY E{ws};
            pg8::gemm_phase<pg8::EpiY, pg8::StaticOrder, PG8_ALIGN, PG8_SP2>(lds, g, S, E);
            SEAM(p0 + 6);
        }
        if (IN(p0 + 7)) { res_phase(nullptr, ws, l * 3 + 1, G); SEAM(p0 + 7); }
        if (IN(p0 + 8)) {
            pg8::Gemm g{(const pg8::bf16_t*)(ws + WS_XB), (const pg8::bf16_t*)(ws + WS_WGU) + (size_t)l * 2 * D_FF * DM, M, 2 * D_FF, DM}; pg8::StaticOrder S; S.init(M, 2 * D_FF, G, opaque_bid());
            pg8::EpiGU E{ws};
            pg8::gemm_phase<pg8::EpiGU, pg8::StaticOrder, PG8_ALIGN, PG8_SP2>(lds, g, S, E);
            SEAM(p0 + 8);
        }
        if (IN(p0 + 9)) {
            pg8::Gemm g{(const pg8::bf16_t*)(ws + WS_F), (const pg8::bf16_t*)(ws + WS_WDN) + (size_t)l * DM * D_FF, M, DM, D_FF}; pg8::StaticOrder S; S.init(M, DM, G, opaque_bid());
            pg8::EpiY E{ws};
            pg8::gemm_phase<pg8::EpiY, pg8::StaticOrder, PG8_ALIGN, PG8_SP2>(lds, g, S, E);
            SEAM(p0 + 9);
        }
        if (IN(p0 + 10)) { res_phase(l == DEPTH - 1 ? a.out : nullptr, ws, l * 3 + 2, G); SEAM(p0 + 10); }
    }
#undef IN
#undef SEAM
}

extern "C" void kernel_launch(void* const* d_in, const int* in_sizes, int n_in, void* d_out, int out_size, void* d_ws, size_t ws_size, hipStream_t stream) {
    static int grid = 0;
    if (grid == 0) {
        if (n_in != 23 || in_sizes[0] != M * DM || out_size != M * DM || ws_size < WS_END) { fprintf(stderr, "kernel_launch: unexpected shapes (n_in %d, in0 %d, out %d, ws %zu < %zu)\n", n_in, n_in > 0 ? in_sizes[0] : -1, out_size, ws_size, (size_t)WS_END); grid = -1; return; }
        int dev = 0, cus = 0, per_cu = 0;
        (void)hipGetDevice(&dev); (void)hipDeviceGetAttribute(&cus, hipDeviceAttributeMultiprocessorCount, dev);
        if (hipFuncSetAttribute((const void*)mk_fwd, hipFuncAttributeMaxDynamicSharedMemorySize, LDS_BYTES) != hipSuccess) fprintf(stderr, "kernel_launch: hipFuncSetAttribute failed\n");
        if (hipOccupancyMaxActiveBlocksPerMultiprocessor(&per_cu, (const void*)mk_fwd, NTHREADS, LDS_BYTES) != hipSuccess || per_cu < 1) { fprintf(stderr, "kernel_launch: occupancy query says %d; using 1 per CU\n", per_cu); per_cu = 1; }
        (void)hipGetLastError();
        grid = cus * per_cu; if (grid <= 0) grid = 256;
    }
    if (grid < 0) return;
    Args a{};
    for (int i = 0; i < 23; ++i) a.in[i] = d_in[i];
    a.out = (float*)d_out; a.ws = (unsigned char*)d_ws;
#if MK_PER_PHASE
    for (int ph = 0; ph < N_PHASES; ++ph) { a.ph_lo = ph; a.ph_hi = ph + 1; hipLaunchKernelGGL(mk_fwd, dim3(grid), dim3(NTHREADS), LDS_BYTES, stream, a); }
#else
    a.ph_lo = 0; a.ph_hi = N_PHASES;
    void* args[] = {&a};
    const hipError_t e = hipLaunchCooperativeKernel((const void*)mk_fwd, dim3(grid), dim3(NTHREADS), args, LDS_BYTES, stream);
    if (e != hipSuccess) fprintf(stderr, "kernel_launch: cooperative launch failed: %s (grid %d)\n", hipGetErrorString(e), grid);
#endif
}
```

```cpp
#include <hip/hip_runtime.h>
#include <hip/hip_cooperative_groups.h>
#include <cstdio>
#include <cstdint>
namespace cg = cooperative_groups;

#ifndef MK_PER_PHASE
#define MK_PER_PHASE 0
#endif

typedef __attribute__((address_space(3))) unsigned char lds_u8;
constexpr int DM = 1024, NBATCH = 8, SEQ = 4096, DEPTH = 4, MEML = 256, M = NBATCH * SEQ, MMEM = NBATCH * MEML, D_IN = 1536, D_FF = 2816;
constexpr float EPS = 1e-6f, LOG2E = 1.4426950408889634f;
constexpr int NWAVES = 8, NTHREADS = 512;
constexpr int LDS_BYTES = 147456;
constexpr size_t MiB = 1u << 20;
constexpr size_t WS_WIN = 0, WS_WO = 12 * MiB, WS_WXQ = 20 * MiB, WS_WXO = 28 * MiB, WS_WGU = 36 * MiB, WS_WDN = 80 * MiB, WS_WXKV = 102 * MiB;
constexpr size_t WS_WM = 118 * MiB, WS_PWT = WS_WM + 512 * 1024, WS_RS = WS_PWT + 128 * 1024, WS_YSQ = 468 * MiB;
constexpr size_t WS_PAR = WS_RS + 128 * 1024, PAR_VG = 0, PAR_BS = 1024, PAR_PSC = 3072, PAR_SNK = 4096, PAR_GPOST = 4160;
constexpr size_t WS_COS = 120 * MiB, WS_SIN = 124 * MiB, WS_KM = 128 * MiB, WS_VTM = 144 * MiB, WS_MEMN = 160 * MiB, WS_XB = 164 * MiB, WS_Y = 228 * MiB, WS_R = 292 * MiB;
constexpr size_t WS_U = WS_R, WS_VNT = WS_R + 16 * MiB, WS_P = WS_R + 32 * MiB, WS_Q = WS_R + 48 * MiB, WS_K = WS_R + 80 * MiB, WS_VT = WS_R + 88 * MiB, WS_BUFA = WS_R + 96 * MiB, WS_F = WS_R;
constexpr size_t WS_BAR = WS_YSQ + 2 * MiB;
constexpr size_t WS_END = WS_BAR + 1 * MiB;
static_assert(WS_YSQ == WS_R + 176 * MiB && WS_PAR + (PAR_GPOST + DEPTH * 3 * DM) * 4 <= WS_COS, "ws map");
static_assert((size_t)M * D_FF * 2 <= 176 * MiB, "f fits");


namespace pg8 {
#define PG8_LAS __attribute__((address_space(3)))
typedef unsigned short bf16_t;
typedef short bf16x8 __attribute__((ext_vector_type(8)));
typedef float f32x4 __attribute__((ext_vector_type(4)));
typedef unsigned u32x4 __attribute__((ext_vector_type(4)));
constexpr int BM = 256, BK = 64, HALF = 128, HTB = HALF * BK * 2  , STAGE_BYTES = 8 * HTB, NXCD = 8, WGM = 8;

__host__ __device__ __forceinline__ int lds_byte(int r, int c) { const int st = (r >> 4) * 2 + (c >> 5), rr = r & 15, cc = c & 31, ob = rr * 64 + cc * 2; return st * 1024 + (ob ^ (((ob >> 9) & 1) << 5)); }
__host__ __device__ __forceinline__ void stage_rc(int b, int& R, int& C) { const int st = b / 1024, sb = b % 1024, swz = sb ^ (((sb >> 9) & 1) << 5); R = (st >> 1) * 16 + swz / 64; C = (st & 1) * 32 + (swz % 64) / 2; }
__host__ __device__ __forceinline__ int perm32(int rho) { const int n = rho >> 4, i = rho & 15; return 8 * (i >> 2) + 4 * n + (i & 3); }

struct Unit { int pm, pn; };
struct Gemm { const bf16_t* A; const bf16_t* Bt; int M, N, K; };

struct StaticOrder {
    int nM, nN, nwg, G, c;
    __host__ __device__ void init(int M, int N, int G_, int c_) { nM = M / BM; nN = N / BM; nwg = nM * nN; G = G_; c = c_; }
    __host__ __device__ bool next(int i, Unit& u) const {
        const long L = (long)i * G + c; if (L >= nwg) return false;
        int wgid = (int)L; { const int q = nwg / NXCD, r = nwg % NXCD, xcd = wgid % NXCD, off = wgid / NXCD; wgid = (xcd < r ? xcd * (q + 1) : r * (q + 1) + (xcd - r) * q) + off; }
        const int nig = WGM * nN, gid = wgid / nig, fm = gid * WGM, gsz = (nM - fm) < WGM ? (nM - fm) : WGM;
        u.pm = fm + ((wgid % nig) % gsz); u.pn = (wgid % nig) / gsz; return true;
    }
    __device__ __forceinline__ void a_ready(const Unit&) const {}
    __device__ __forceinline__ void done(const Unit&) const {}
};


typedef unsigned u32x2 __attribute__((ext_vector_type(2)));
typedef float f32x2 __attribute__((ext_vector_type(2)));
typedef __bf16 bf16v2 __attribute__((ext_vector_type(2)));
__device__ __forceinline__ unsigned pk2(float lo, float hi) { f32x2 v = {lo, hi}; bf16v2 b = __builtin_convertvector(v, bf16v2); return __builtin_bit_cast(unsigned, b); }
__device__ __forceinline__ bf16_t f2bf1(float v) { return (bf16_t)(pk2(v, 0.f) & 0xffffu); }
__device__ __forceinline__ u32x4 pk8(const f32x4 a, const f32x4 b) { u32x4 w; w.x = pk2(a[0], a[1]); w.y = pk2(a[2], a[3]); w.z = pk2(b[0], b[1]); w.w = pk2(b[2], b[3]); return w; }
__device__ __forceinline__ float gelu_tanh(float x) {
    const float u = x * (1.f + 0.044715f * x * x);
    const float e = __builtin_amdgcn_exp2f(u * (-2.f * 0.7978845608028654f * 1.4426950408889634f));
    return x * __builtin_amdgcn_rcpf(1.f + e);
}
__device__ __forceinline__ float silu_f(float x) { return x * __builtin_amdgcn_rcpf(1.f + __builtin_amdgcn_exp2f(x * -1.4426950408889634f)); }
constexpr float NORM_EPS = 1e-6f;
constexpr float QSCALE_SWA = 0.125f * 1.4426950408889634f;
constexpr float QSCALE_X = 0.0625f * 1.4426950408889634f;

struct EpiIn {
    static constexpr bool PERM = true, AFTER_DRAIN = false;
    unsigned char* ws; int l;
    __device__ __forceinline__ void operator()(const f32x4 (&acc)[2][2][4][2], const Unit& u, int wr, int wc, int fr, int fq) const {
        asm volatile("" : "+v"(fr), "+v"(fq), "+s"(wr), "+s"(wc));
        const float* rs = (const float*)(ws + WS_RS); bf16_t* U = (bf16_t*)(ws + WS_U); bf16_t* VNT = (bf16_t*)(ws + WS_VNT); bf16_t* P = (bf16_t*)(ws + WS_P); bf16_t* Q = (bf16_t*)(ws + WS_Q);
        bf16_t* Kb = (bf16_t*)(ws + WS_K); bf16_t* VT = (bf16_t*)(ws + WS_VT); const float* vgain = (const float*)(ws + WS_PAR) + PAR_VG + l * 256;
        const float* cosT = (const float*)(ws + WS_COS); const float* sinT = (const float*)(ws + WS_SIN);
        const int pn = u.pn;
        const int rbase = u.pm * BM + wr * 64 + fr;
        if (pn == 0 || pn == 2) {
            bf16_t* O = (pn == 0) ? U : P;
#pragma unroll
            for (int ai = 0; ai < 2; ++ai)
#pragma unroll
                for (int m = 0; m < 4; ++m) { const int r = rbase + ai * HALF + m * 16; const float s = rs[r];
#pragma unroll
                    for (int bj = 0; bj < 2; ++bj) { f32x4 v0 = acc[ai][bj][m][0] * s, v1 = acc[ai][bj][m][1] * s;
                        if (pn == 0) {
#pragma unroll
                            for (int j = 0; j < 4; ++j) { v0[j] = gelu_tanh(v0[j]); v1[j] = gelu_tanh(v1[j]); } }
                        *(u32x4*)(O + (size_t)r * 256 + bj * HALF + wc * 32 + fq * 8) = pk8(v0, v1); } asm volatile("" ::: "memory"); }
        } else if (pn == 1) {
            const int g = wc;
#pragma unroll
            for (int ai = 0; ai < 2; ++ai)
#pragma unroll
                for (int m = 0; m < 4; ++m) { const int r = rbase + ai * HALF + m * 16; const float s = rs[r];
                    float v[2][2][4]; float ss = 0.f;
#pragma unroll
                    for (int bj = 0; bj < 2; ++bj)
#pragma unroll
                        for (int n = 0; n < 2; ++n)
#pragma unroll
                            for (int j = 0; j < 4; ++j) { const float t = gelu_tanh(acc[ai][bj][m][n][j] * s); v[bj][n][j] = t; ss += t * t; }
                    ss += __shfl_xor(ss, 16); ss += __shfl_xor(ss, 32);
                    const float rn = rsqrtf(ss * (1.f / 64.f) + NORM_EPS);
                    const int chunk = r >> 7, sidx = r & 127;
                    bf16_t* base = VNT + ((size_t)(chunk * 4 + g) * 64) * 128 + sidx;
#pragma unroll
                    for (int bj = 0; bj < 2; ++bj)
#pragma unroll
                        for (int n = 0; n < 2; ++n)
#pragma unroll
                            for (int j = 0; j < 4; ++j) { const int dd = 32 * bj + 8 * fq + 4 * n + j;
                                base[(size_t)dd * 128] = f2bf1(v[bj][n][j] * rn * vgain[g * 64 + dd]); } asm volatile("" ::: "memory"); }
        } else {
            const int ii = 4 * (wc & 1) + fq;
#pragma unroll
            for (int ai = 0; ai < 2; ++ai)
#pragma unroll
                for (int m = 0; m < 4; ++m) { const int r = rbase + ai * HALF + m * 16; const float s = rs[r];
                    const f32x4 c4 = *(const f32x4*)(cosT + (size_t)r * 32 + 4 * ii), s4 = *(const f32x4*)(sinT + (size_t)r * 32 + 4 * ii);
#pragma unroll
                    for (int bj = 0; bj < 2; ++bj) {
                        if (pn == 5 && bj == 1) {
                            const int hv = wc >> 1, b = r >> 12, nblk = (r >> 7) & 31;
                            bf16_t* base = VT + ((size_t)((b * 2 + hv) * 32 + nblk) * 64 + 32 * (wc & 1) + 8 * fq) * 128 + (r & 127);
#pragma unroll
                            for (int n = 0; n < 2; ++n)
#pragma unroll
                                for (int j = 0; j < 4; ++j) base[(4 * n + j) * 128] = f2bf1(acc[ai][bj][m][n][j] * s);
                        } else {
                            const float sc = (pn == 5) ? s : s * QSCALE_SWA;
                            const f32x4 x1 = acc[ai][bj][m][0] * sc, x2 = acc[ai][bj][m][1] * sc;
                            const f32x4 o1 = x1 * c4 - x2 * s4, o2 = x2 * c4 + x1 * s4;
                            bf16_t* dst = (pn == 5) ? (Kb + (size_t)r * 128 + wc * 32 + fq * 8) : (Q + (size_t)r * 512 + (pn - 3) * 256 + bj * HALF + wc * 32 + fq * 8);
                            *(u32x4*)dst = pk8(o1, o2);
                        } } asm volatile("" ::: "memory"); }
        }
    }
};

struct EpiY {
    static constexpr bool PERM = true, AFTER_DRAIN = false;
    unsigned char* ws;
    __device__ __forceinline__ void operator()(const f32x4 (&acc)[2][2][4][2], const Unit& u, int wr, int wc, int fr, int fq) const {
        asm volatile("" : "+v"(fr), "+v"(fq), "+s"(wr), "+s"(wc));
        bf16_t* Y = (bf16_t*)(ws + WS_Y); float* ysq = (float*)(ws + WS_YSQ);
        const int rbase = u.pm * BM + wr * 64 + fr, cbase = u.pn * BM + wc * 32 + fq * 8;
#pragma unroll
        for (int ai = 0; ai < 2; ++ai)
#pragma unroll
            for (int m = 0; m < 4; ++m) { const int r = rbase + ai * HALF + m * 16; float ss = 0.f;
#pragma unroll
                for (int bj = 0; bj < 2; ++bj) { const f32x4 v0 = acc[ai][bj][m][0], v1 = acc[ai][bj][m][1];
                    ss += (v0[0] * v0[0] + v0[1] * v0[1]) + (v0[2] * v0[2] + v0[3] * v0[3]) + (v1[0] * v1[0] + v1[1] * v1[1]) + (v1[2] * v1[2] + v1[3] * v1[3]);
                    *(u32x4*)(Y + (size_t)r * 1024 + cbase + bj * HALF) = pk8(v0, v1); }
                ss += __shfl_xor(ss, 16); ss += __shfl_xor(ss, 32);
                if (fq == 0) ysq[(size_t)r * 16 + u.pn * 4 + wc] = ss; asm volatile("" ::: "memory"); }
    }
};

struct EpiQx {
    static constexpr bool PERM = true, AFTER_DRAIN = false;
    unsigned char* ws;
    __device__ __forceinline__ void operator()(const f32x4 (&acc)[2][2][4][2], const Unit& u, int wr, int wc, int fr, int fq) const {
        asm volatile("" : "+v"(fr), "+v"(fq), "+s"(wr), "+s"(wc));
        const float* rs = (const float*)(ws + WS_RS); bf16_t* O = (bf16_t*)(ws + WS_BUFA);
        const int rbase = u.pm * BM + wr * 64 + fr, cbase = u.pn * BM + wc * 32 + fq * 8;
#pragma unroll
        for (int ai = 0; ai < 2; ++ai)
#pragma unroll
            for (int m = 0; m < 4; ++m) { const int r = rbase + ai * HALF + m * 16; const float s = rs[r] * QSCALE_X;
#pragma unroll
                for (int bj = 0; bj < 2; ++bj) *(u32x4*)(O + (size_t)r * 1024 + cbase + bj * HALF) = pk8(acc[ai][bj][m][0] * s, acc[ai][bj][m][1] * s); }
    }
};

struct EpiKV {
    static constexpr bool PERM = true, AFTER_DRAIN = false;
    unsigned char* ws;
    __device__ __forceinline__ void operator()(const f32x4 (&acc)[2][2][4][2], const Unit& u, int wr, int wc, int fr, int fq) const {
        asm volatile("" : "+v"(fr), "+v"(fq), "+s"(wr), "+s"(wc));
        bf16_t* KM = (bf16_t*)(ws + WS_KM); bf16_t* VTM = (bf16_t*)(ws + WS_VTM);
        const int layer = u.pn >> 3, t = u.pn & 7;
        const int rbase = u.pm * BM + wr * 64 + fr;
#pragma unroll
        for (int ai = 0; ai < 2; ++ai)
#pragma unroll
            for (int m = 0; m < 4; ++m) { const int r = rbase + ai * HALF + m * 16;
#pragma unroll
                for (int bj = 0; bj < 2; ++bj) {
                    if (t < 4) *(u32x4*)(KM + ((size_t)layer * 2048 + r) * 1024 + t * 256 + bj * HALF + wc * 32 + fq * 8) = pk8(acc[ai][bj][m][0], acc[ai][bj][m][1]);
                    else { const int b = r >> 8, mm = r & 255, head = t - 4;
                        bf16_t* base = VTM + ((size_t)((layer * 8 + b) * 4 + head) * 256) * 256 + mm;
#pragma unroll
                        for (int n = 0; n < 2; ++n)
#pragma unroll
                            for (int j = 0; j < 4; ++j) { const int d = bj * HALF + wc * 32 + fq * 8 + 4 * n + j; base[(size_t)d * 256] = f2bf1(acc[ai][bj][m][n][j]); } } } }
    }
};

struct EpiGU {
    static constexpr bool PERM = true, AFTER_DRAIN = false;
    unsigned char* ws;
    __device__ __forceinline__ void operator()(const f32x4 (&acc)[2][2][4][2], const Unit& u, int wr, int wc, int fr, int fq) const {
        asm volatile("" : "+v"(fr), "+v"(fq), "+s"(wr), "+s"(wc));
        const float* rs = (const float*)(ws + WS_RS); bf16_t* F = (bf16_t*)(ws + WS_F);
        const int rbase = u.pm * BM + wr * 64 + fr, cbase = u.pn * 128 + wc * 16 + fq * 4;
#pragma unroll
        for (int ai = 0; ai < 2; ++ai)
#pragma unroll
            for (int m = 0; m < 4; ++m) { const int r = rbase + ai * HALF + m * 16; const float s = rs[r];
#pragma unroll
                for (int bj = 0; bj < 2; ++bj) { const f32x4 g = acc[ai][bj][m][0] * s, up = acc[ai][bj][m][1] * s;
                    u32x2 w; w.x = pk2(silu_f(g[0]) * up[0], silu_f(g[1]) * up[1]); w.y = pk2(silu_f(g[2]) * up[2], silu_f(g[3]) * up[3]);
                    *(u32x2*)(F + (size_t)r * 2816 + cbase + bj * 64) = w; } }
    }
};

template <class Epi, class Sched, bool ALIGN_EPI = false, bool SP2 = false>
__device__ __forceinline__ void gemm_phase(PG8_LAS unsigned char* lds, const Gemm g, const Sched& S, const Epi& E) {
    int tid_ = threadIdx.x; asm volatile("" : "+v"(tid_));
    const int tid = tid_, wid = __builtin_amdgcn_readfirstlane(tid >> 6), lane = tid & 63, wr = wid >> 2, wc = wid & 3, fr = lane & 15, fq = lane >> 4;
    const int K = g.K, nt = K / BK;
    unsigned voffA[2], voffB[2];
#pragma unroll
    for (int i = 0; i < 2; ++i) { int R, C; stage_rc(tid * 16 + i * 8192, R, C); const int Rb = Epi::PERM ? ((R & ~31) + perm32(R & 31)) : R;
        voffA[i] = (unsigned)(R * K + C) * 2u; voffB[i] = (unsigned)(Rb * K + C) * 2u; }
    const size_t kstep = (size_t)(BK * 2);
    const size_t hstep = (size_t)HALF * K * 2;
    const size_t tstep = 2 * hstep;
    const unsigned ldsw = (unsigned)wid * 1024u;
    const int aoff = lds_byte(wr * 64 + fr, fq * 8), boff = lds_byte(wc * 32 + fr, fq * 8);
#define PG8_SA(b, h) (((b) * 2 + (h)) * HTB)
#define PG8_SB(b, h) ((4 + (b) * 2 + (h)) * HTB)
#define PG8_STAGE(bufoff, gbase, voff) do { _Pragma("unroll") for (int _i = 0; _i < 2; ++_i) \
        __builtin_amdgcn_global_load_lds((const unsigned*)((const char*)(gbase) + (voff)[_i]), (PG8_LAS unsigned*)(lds + (bufoff) + ldsw + _i * 8192), 16, 0, 0); } while (0)
#define PG8_LDA(dst, b, h) do { _Pragma("unroll") for (int m = 0; m < 4; ++m) _Pragma("unroll") for (int k = 0; k < 2; ++k) dst[m][k] = *(const PG8_LAS bf16x8*)(lds + PG8_SA(b, h) + aoff + m * 2048 + k * 1024); } while (0)
#define PG8_LDB(dst, b, h) do { _Pragma("unroll") for (int n = 0; n < 2; ++n) _Pragma("unroll") for (int k = 0; k < 2; ++k) dst[n][k] = *(const PG8_LAS bf16x8*)(lds + PG8_SB(b, h) + boff + n * 2048 + k * 1024); } while (0)
#define PG8_MMA(ai, bj, At, Bt) do { __builtin_amdgcn_s_setprio(1); _Pragma("unroll") for (int m = 0; m < 4; ++m) _Pragma("unroll") for (int n = 0; n < 2; ++n) _Pragma("unroll") for (int k = 0; k < 2; ++k) \
        acc[ai][bj][m][n] = __builtin_amdgcn_mfma_f32_16x16x32_bf16(Bt[n][k], At[m][k], acc[ai][bj][m][n], 0, 0, 0); __builtin_amdgcn_s_setprio(0); } while (0)
#define PG8_WAIT_V(n) asm volatile("s_waitcnt vmcnt(" #n ")" ::: "memory")
#define PG8_WAIT_L(n) asm volatile("s_waitcnt lgkmcnt(" #n ")" ::: "memory")
#define PG8_BAR __builtin_amdgcn_s_barrier()
#define PG8_SCHED __builtin_amdgcn_sched_barrier(0)
    Unit cur, nxt; int ui = 0;
    if (!S.next(0, cur)) return;
    f32x4 acc[2][2][4][2];
#pragma unroll
    for (int a = 0; a < 2; ++a)
#pragma unroll
        for (int b = 0; b < 2; ++b)
#pragma unroll
            for (int m = 0; m < 4; ++m)
#pragma unroll
                for (int n = 0; n < 2; ++n) acc[a][b][m][n] = (f32x4){0.f, 0.f, 0.f, 0.f};
    bf16x8 At[4][2], B0[2][2], B1[2][2];
    const char* cA = (const char*)g.A + (size_t)cur.pm * tstep; const char* cB = (const char*)g.Bt + (size_t)cur.pn * tstep;
    S.a_ready(cur);
    if constexpr (SP2) {
        PG8_STAGE(PG8_SB(0, 0), cB, voffB); PG8_STAGE(PG8_SB(0, 1), cB + hstep, voffB); PG8_STAGE(PG8_SA(0, 0), cA, voffA); PG8_STAGE(PG8_SA(0, 1), cA + hstep, voffA);
        if (wr == 1) PG8_BAR;
        PG8_WAIT_V(2); PG8_BAR;
        PG8_STAGE(PG8_SB(1, 0), cB + kstep, voffB); PG8_STAGE(PG8_SA(1, 0), cA + kstep, voffA); PG8_STAGE(PG8_SB(1, 1), cB + hstep + kstep, voffB);
        PG8_WAIT_V(6); PG8_BAR;
    } else {
        PG8_STAGE(PG8_SB(0, 0), cB, voffB); PG8_STAGE(PG8_SA(0, 0), cA, voffA); PG8_STAGE(PG8_SB(0, 1), cB + hstep, voffB); PG8_STAGE(PG8_SA(0, 1), cA + hstep, voffA);
        if (wr == 1) PG8_BAR;
        PG8_WAIT_V(4); PG8_BAR;
        PG8_STAGE(PG8_SB(1, 0), cB + kstep, voffB); PG8_STAGE(PG8_SA(1, 0), cA + kstep, voffA); PG8_STAGE(PG8_SB(1, 1), cB + hstep + kstep, voffB);
        PG8_WAIT_V(6); PG8_BAR;
    }
    for (;;) {
        const bool has_next = S.next(ui + 1, nxt);
        const char* nA = has_next ? (const char*)g.A + (size_t)nxt.pm * tstep : cA; const char* nB = has_next ? (const char*)g.Bt + (size_t)nxt.pn * tstep : cB;
        for (int t = 0; t < nt; t += 2) {
            const bool last = (t == nt - 2);
            const char* a1 = cA + (size_t)(t + 1) * kstep;
            const char* a2 = last ? nA : cA + (size_t)(t + 2) * kstep; const char* b2 = last ? nB : cB + (size_t)(t + 2) * kstep;
            const char* a3 = a2 + kstep; const char* b3 = b2 + kstep;
            if (last && has_next) S.a_ready(nxt);
            if constexpr (SP2) {
            PG8_LDB(B0, 0, 0); PG8_LDB(B1, 0, 1); PG8_SCHED; PG8_LDA(At, 0, 0); PG8_STAGE(PG8_SA(1, 1), a1 + hstep, voffA);
            PG8_WAIT_V(8); PG8_WAIT_L(0); PG8_BAR; PG8_MMA(0, 0, At, B0); PG8_MMA(0, 1, At, B1); PG8_BAR; PG8_SCHED;
            PG8_LDA(At, 0, 1); PG8_STAGE(PG8_SB(0, 0), b2, voffB); PG8_STAGE(PG8_SB(0, 1), b2 + hstep, voffB); PG8_STAGE(PG8_SA(0, 0), a2, voffA);
            PG8_WAIT_V(8); PG8_WAIT_L(0); PG8_BAR; PG8_MMA(1, 0, At, B0); PG8_MMA(1, 1, At, B1); PG8_BAR; PG8_SCHED;
            PG8_LDB(B0, 1, 0); PG8_LDB(B1, 1, 1); PG8_SCHED; PG8_LDA(At, 1, 0); PG8_STAGE(PG8_SA(0, 1), a2 + hstep, voffA);
            PG8_WAIT_V(8); PG8_WAIT_L(0); PG8_BAR; PG8_MMA(0, 0, At, B0); PG8_MMA(0, 1, At, B1); PG8_BAR; PG8_SCHED;
            PG8_LDA(At, 1, 1); PG8_STAGE(PG8_SB(1, 0), b3, voffB); PG8_STAGE(PG8_SB(1, 1), b3 + hstep, voffB); PG8_STAGE(PG8_SA(1, 0), a3, voffA);
            PG8_WAIT_V(8); PG8_WAIT_L(0); PG8_BAR; PG8_MMA(1, 0, At, B0); PG8_MMA(1, 1, At, B1); PG8_BAR; PG8_SCHED;
            } else {
            PG8_LDB(B0, 0, 0); PG8_SCHED; PG8_LDA(At, 0, 0); PG8_STAGE(PG8_SA(1, 1), a1 + hstep, voffA);
            PG8_WAIT_L(8); PG8_BAR; PG8_WAIT_L(0); PG8_MMA(0, 0, At, B0); PG8_BAR; PG8_SCHED;
            PG8_LDB(B1, 0, 1); PG8_STAGE(PG8_SB(0, 0), b2, voffB);
            PG8_BAR; PG8_WAIT_L(0); PG8_MMA(0, 1, At, B1); PG8_BAR;
            PG8_LDA(At, 0, 1); PG8_STAGE(PG8_SA(0, 0), a2, voffA);
            PG8_BAR; PG8_WAIT_L(0); PG8_MMA(1, 0, At, B0); PG8_BAR; PG8_SCHED;
            PG8_STAGE(PG8_SB(0, 1), b2 + hstep, voffB);
            PG8_WAIT_V(6); PG8_BAR; PG8_MMA(1, 1, At, B1); PG8_BAR;
            PG8_LDB(B0, 1, 0); PG8_SCHED; PG8_LDA(At, 1, 0); PG8_STAGE(PG8_SA(0, 1), a2 + hstep, voffA);
            PG8_WAIT_L(8); PG8_BAR; PG8_WAIT_L(0); PG8_MMA(0, 0, At, B0); PG8_BAR; PG8_SCHED;
            PG8_LDB(B1, 1, 1); PG8_STAGE(PG8_SB(1, 0), b3, voffB);
            PG8_BAR; PG8_WAIT_L(0); PG8_MMA(0, 1, At, B1); PG8_BAR;
            PG8_LDA(At, 1, 1); PG8_STAGE(PG8_SA(1, 0), a3, voffA);
            PG8_BAR; PG8_WAIT_L(0); PG8_MMA(1, 0, At, B0); PG8_BAR; PG8_SCHED;
            PG8_STAGE(PG8_SB(1, 1), b3 + hstep, voffB);
            PG8_WAIT_V(6); PG8_BAR; PG8_MMA(1, 1, At, B1); PG8_BAR;
            }
        }
        if constexpr (ALIGN_EPI) { if (wr == 0) PG8_BAR; }
        if constexpr (!Epi::AFTER_DRAIN) { E(acc, cur, wr, wc, fr, fq); S.done(cur); }
        if (!has_next) break;
#pragma unroll
        for (int a = 0; a < 2; ++a)
#pragma unroll
            for (int b = 0; b < 2; ++b)
#pragma unroll
                for (int m = 0; m < 4; ++m)
#pragma unroll
                    for (int n = 0; n < 2; ++n) acc[a][b][m][n] = (f32x4){0.f, 0.f, 0.f, 0.f};
        cur = nxt; cA = nA; cB = nB; ++ui;
        if constexpr (ALIGN_EPI) { if (wr == 1) PG8_BAR; }
    }
    PG8_WAIT_V(0);
    if constexpr (!ALIGN_EPI) { if (wr == 0) PG8_BAR; }
    PG8_BAR;
    if constexpr (Epi::AFTER_DRAIN) { E.fused(acc, cur, wr, wc, fr, fq, lds, wid, lane); S.done(cur); }
#undef PG8_SA
#undef PG8_SB
#undef PG8_STAGE
#undef PG8_LDA
#undef PG8_LDB
#undef PG8_MMA
#undef PG8_WAIT_V
#undef PG8_WAIT_L
#undef PG8_BAR
#undef PG8_SCHED
}
}

#define LAS __attribute__((address_space(3)))
#define DI __device__ __forceinline__
typedef unsigned short bf16;
typedef short bf16x8 __attribute__((ext_vector_type(8)));
typedef short s16x4 __attribute__((ext_vector_type(4)));
typedef float f32x4 __attribute__((ext_vector_type(4)));
typedef float f32x16 __attribute__((ext_vector_type(16)));
typedef unsigned u32x4 __attribute__((ext_vector_type(4)));
typedef unsigned u32x2 __attribute__((ext_vector_type(2)));
#define MFMA32(a, b, c) __builtin_amdgcn_mfma_f32_32x32x16_bf16((a), (b), (c), 0, 0, 0)
using pg8::pk2; using pg8::f2bf1;
DI float bf2f(unsigned v) { return __uint_as_float(v << 16); }
DI int crow(int i, int h) { return (i & 3) + 8 * (i >> 2) + 4 * h; }

__device__ const float INV_FREQ[32] = {1.000000000e+00f, 7.498942614e-01f, 5.623413324e-01f, 4.216965139e-01f, 3.162277639e-01f, 2.371373773e-01f, 1.778279394e-01f, 1.333521307e-01f,
    1.000000015e-01f, 7.498941571e-02f, 5.623413250e-02f, 4.216965288e-02f, 3.162277490e-02f, 2.371373773e-02f, 1.778279431e-02f, 1.333521493e-02f,
    9.999999776e-03f, 7.498941850e-03f, 5.623413250e-03f, 4.216964822e-03f, 3.162277630e-03f, 2.371373586e-03f, 1.778279431e-03f, 1.333521446e-03f,
    1.000000047e-03f, 7.498942432e-04f, 5.623413017e-04f, 4.216965172e-04f, 3.162277571e-04f, 2.371373703e-04f, 1.778279402e-04f, 1.333521504e-04f};

struct Args { const void* in[23]; float* out; unsigned char* ws; int ph_lo, ph_hi; };

DI int opaque_tid() { int t = threadIdx.x; asm volatile("" : "+v"(t)); return t; }
DI int opaque_bid() { int b = blockIdx.x; asm volatile("" : "+s"(b)); return b; }
DI float wave_sum(float v) {
#pragma unroll
    for (int o = 1; o < 64; o <<= 1) v += __shfl_xor(v, o);
    return v;
}

DI int rowmap(int mode, int n) {
    if (mode == 1) {
        if (n < 256) return n;
        if (n < 512) { const int q = n - 256, g = q >> 6, dd = q & 63; return 256 + 128 * (dd >> 5) + 32 * g + (dd & 31); }
        if (n < 768) return n;
        if (n < 1408) { const int base = n & ~63, d = n & 63; return base + 8 * ((d & 31) >> 2) + 4 * (d >> 5) + (d & 3); }
        return n;
    }
    if (mode == 2) {
        if (n < D_FF) return 8 * (n >> 2) + (n & 3);
        const int q = n - D_FF; return 8 * (q >> 2) + 4 + (q & 3);
    }
    return n;
}
DI void transpose_item(const float* W, int K, int N, bf16* WT, int mode, const float* gain, LAS float* scr, int item, int lane) {
    const int nblk = N / 32, kb = item / nblk, nbk = item % nblk, k0 = 64 * kb, n0 = 32 * nbk;
#pragma unroll 8
    for (int i = 0; i < 32; ++i) { const int kk = 2 * i + (lane >> 5); float v = W[(size_t)(k0 + kk) * N + n0 + (lane & 31)]; if (gain) v *= gain[k0 + kk]; scr[kk * 33 + (lane & 31)] = v; }
    asm volatile("s_waitcnt lgkmcnt(0)" ::: "memory"); __builtin_amdgcn_wave_barrier();
    const int c = lane & 7;
#pragma unroll
    for (int j = 0; j < 4; ++j) { const int n = (lane >> 3) + 8 * j; const LAS float* s = scr + (8 * c) * 33 + n;
        u32x4 o; o.x = pk2(s[0 * 33], s[1 * 33]); o.y = pk2(s[2 * 33], s[3 * 33]); o.z = pk2(s[4 * 33], s[5 * 33]); o.w = pk2(s[6 * 33], s[7 * 33]);
        *(u32x4*)(WT + (size_t)rowmap(mode, n0 + n) * K + k0 + 8 * c) = o; }
    asm volatile("s_waitcnt lgkmcnt(0)" ::: "memory"); __builtin_amdgcn_wave_barrier();
}

DI void prologue(const Args& a, LAS unsigned char* lds, int G) {
    unsigned char* ws = a.ws;
    const int tid = threadIdx.x, lane = tid & 63, wave = tid >> 6;
    const int gw = blockIdx.x * NWAVES + wave, NGW = G * NWAVES;
    const int gt = blockIdx.x * NTHREADS + tid, NGT = G * NTHREADS;
    LAS float* scr = (LAS float*)(lds + wave * 16384);
    constexpr int I_IN = 16 * 48, I_O = 16 * 32, I_GU = 16 * 176, I_DN = 44 * 32, I_KV = 16 * 64;
    constexpr int PER_L = I_IN + 3 * I_O + I_GU + I_DN + I_KV;
    for (int it = gw; it < DEPTH * PER_L; it += NGW) {
        const int l = it / PER_L; int r = it % PER_L;
        if (r < I_IN) { transpose_item(((const float*)a.in[6]) + (size_t)l * DM * D_IN, DM, D_IN, (bf16*)(ws + WS_WIN) + (size_t)l * D_IN * DM, 1, ((const float*)a.in[4]) + l * DM, scr, r, lane); continue; } r -= I_IN;
        if (r < I_O) { transpose_item(((const float*)a.in[13]) + (size_t)l * DM * DM, DM, DM, (bf16*)(ws + WS_WO) + (size_t)l * DM * DM, 0, nullptr, scr, r, lane); continue; } r -= I_O;
        if (r < I_O) { transpose_item(((const float*)a.in[16]) + (size_t)l * DM * DM, DM, DM, (bf16*)(ws + WS_WXQ) + (size_t)l * DM * DM, 0, ((const float*)a.in[14]) + l * DM, scr, r, lane); continue; } r -= I_O;
        if (r < I_O) { transpose_item(((const float*)a.in[18]) + (size_t)l * DM * DM, DM, DM, (bf16*)(ws + WS_WXO) + (size_t)l * DM * DM, 0, nullptr, scr, r, lane); continue; } r -= I_O;
        if (r < I_GU) { transpose_item(((const float*)a.in[21]) + (size_t)l * DM * 2 * D_FF, DM, 2 * D_FF, (bf16*)(ws + WS_WGU) + (size_t)l * 2 * D_FF * DM, 2, ((const float*)a.in[19]) + l * DM, scr, r, lane); continue; } r -= I_GU;
        if (r < I_DN) { transpose_item(((const float*)a.in[22]) + (size_t)l * D_FF * DM, D_FF, DM, (bf16*)(ws + WS_WDN) + (size_t)l * DM * D_FF, 0, nullptr, scr, r, lane); continue; } r -= I_DN;
        transpose_item(((const float*)a.in[17]) + (size_t)l * DM * 2 * DM, DM, 2 * DM, (bf16*)(ws + WS_WXKV) + (size_t)l * 2 * DM * DM, 0, nullptr, scr, r, lane);
    }
    { bf16* WMk = (bf16*)(ws + WS_WM);
      for (int i = gt; i < DEPTH * 4 * 128 * 128; i += NGT) { const int s = i & 127, t = (i >> 7) & 127; WMk[i] = (s <= t) ? f2bf1(((const float*)a.in[8])[i]) : (bf16)0; }
      bf16* PWT = (bf16*)(ws + WS_PWT);
      for (int i = gt; i < DEPTH * 4 * 64 * 64; i += NGT) { const int c = i & 63, d = (i >> 6) & 63, lg = i >> 12; PWT[i] = f2bf1(((const float*)a.in[10])[(size_t)lg * 4096 + c * 64 + d]); }
      float* par = (float*)(ws + WS_PAR);
      for (int i = gt; i < 1024; i += NGT) par[PAR_VG + i] = ((const float*)a.in[7])[i];
      for (int i = gt; i < 2048; i += NGT) par[PAR_BS + i] = ((const float*)a.in[9])[i];
      for (int i = gt; i < 1024; i += NGT) par[PAR_PSC + i] = ((const float*)a.in[11])[i];
      for (int i = gt; i < 32; i += NGT) par[PAR_SNK + i] = ((const float*)a.in[12])[i];
      for (int i = gt; i < DEPTH * 3 * DM; i += NGT) { const int l = i / (3 * DM), k = (i / DM) % 3, c = i % DM; par[PAR_GPOST + i] = ((const float*)a.in[k == 0 ? 5 : (k == 1 ? 15 : 20)])[l * DM + c]; }
      float* cosT = (float*)(ws + WS_COS); float* sinT = (float*)(ws + WS_SIN);
      for (int i = gt; i < M * 32; i += NGT) {
          const int r = i >> 5, k = i & 31;
          const float ang = (float)((const int*)a.in[2])[r] * INV_FREQ[k];
          const double ad = (double)ang;
          const double q = __builtin_rint(ad * 0.63661977236758134308);
          double rr = __builtin_fma(-q, 1.57079632679489655800e+00, ad); rr = __builtin_fma(-q, 6.12323399573676603587e-17, rr);
          const double x2 = rr * rr;
          double sp = -1.0 / 6227020800.0; sp = sp * x2 + 1.0 / 39916800.0; sp = sp * x2 - 1.0 / 362880.0; sp = sp * x2 + 1.0 / 5040.0; sp = sp * x2 - 1.0 / 120.0; sp = sp * x2 + 1.0 / 6.0; sp = rr - rr * x2 * sp;
          double cp = 1.0 / 87178291200.0; cp = cp * x2 - 1.0 / 479001600.0; cp = cp * x2 + 1.0 / 3628800.0; cp = cp * x2 - 1.0 / 40320.0; cp = cp * x2 + 1.0 / 720.0; cp = cp * x2 - 1.0 / 24.0; cp = cp * x2 + 0.5; cp = 1.0 - x2 * cp;
          const int qi = ((int)q) & 3;
          const double sv = (qi == 0) ? sp : (qi == 1) ? cp : (qi == 2) ? -sp : -cp;
          const double cv = (qi == 0) ? cp : (qi == 1) ? -sp : (qi == 2) ? -cp : sp;
          cosT[i] = (float)cv; sinT[i] = (float)sv;
      }
    }
    { bf16* XB = (bf16*)(ws + WS_XB); float* rsx = (float*)(ws + WS_RS);
      for (int r = gw; r < M; r += NGW) {
          const f32x4* xr = (const f32x4*)(((const float*)a.in[0]) + (size_t)r * DM) + lane; float ss = 0.f;
#pragma unroll
          for (int j = 0; j < 4; ++j) { const f32x4 v = xr[64 * j]; ss += (v[0] * v[0] + v[1] * v[1]) + (v[2] * v[2] + v[3] * v[3]);
              u32x2 w; w.x = pk2(v[0], v[1]); w.y = pk2(v[2], v[3]); *((u32x2*)(XB + (size_t)r * DM) + lane + 64 * j) = w; }
          ss = wave_sum(ss); if (lane == 0) rsx[r] = rsqrtf(ss * (1.f / DM) + EPS);
      }
      bf16* MN = (bf16*)(ws + WS_MEMN);
      for (int r = gw; r < MMEM; r += NGW) {
          const f32x4* xr = (const f32x4*)(((const float*)a.in[1]) + (size_t)r * DM) + lane; f32x4 v[4]; float ss = 0.f;
#pragma unroll
          for (int j = 0; j < 4; ++j) { v[j] = xr[64 * j]; ss += (v[j][0] * v[j][0] + v[j][1] * v[j][1]) + (v[j][2] * v[j][2] + v[j][3] * v[j][3]); }
          ss = wave_sum(ss); const float rn = rsqrtf(ss * (1.f / DM) + EPS);
#pragma unroll
          for (int j = 0; j < 4; ++j) { const f32x4 g = *((const f32x4*)((const float*)a.in[3]) + lane + 64 * j); const f32x4 o = v[j] * rn * g;
              u32x2 w; w.x = pk2(o[0], o[1]); w.y = pk2(o[2], o[3]); *((u32x2*)(MN + (size_t)r * DM) + lane + 64 * j) = w; }
      }
    }
}

DI void res_phase(float* out_final, unsigned char* ws, int gidx, int G) {
    const bf16* Y = (const bf16*)(ws + WS_Y); const float* ysq = (const float*)(ws + WS_YSQ); const float* gpost = (const float*)(ws + WS_PAR) + PAR_GPOST + gidx * DM; bf16* XB = (bf16*)(ws + WS_XB); float* rsx = (float*)(ws + WS_RS);
    const int tid = opaque_tid(), lane = tid & 63, wave = tid >> 6;
    const int gw = opaque_bid() * NWAVES + wave, NGW = G * NWAVES;
    f32x4 g4[4];
#pragma unroll
    for (int j = 0; j < 4; ++j) g4[j] = *((const f32x4*)gpost + lane + 64 * j);
    for (int r = gw; r < M; r += NGW) {
        float ysum = 0.f;
#pragma unroll
        for (int j = 0; j < 4; ++j) { const f32x4 q = *((const f32x4*)(ysq + (size_t)r * 16) + j); ysum += (q[0] + q[1]) + (q[2] + q[3]); }
        const float rn = rsqrtf(ysum * (1.f / DM) + EPS);
        float ss = 0.f;
#pragma unroll
        for (int j = 0; j < 4; ++j) {
            const u32x2 xw = *((const u32x2*)(XB + (size_t)r * DM) + lane + 64 * j);
            const u32x2 yw = *((const u32x2*)(Y + (size_t)r * DM) + lane + 64 * j);
            f32x4 xv; xv[0] = bf2f(xw.x & 0xffffu); xv[1] = bf2f(xw.x >> 16); xv[2] = bf2f(xw.y & 0xffffu); xv[3] = bf2f(xw.y >> 16);
            f32x4 yv; yv[0] = bf2f(yw.x & 0xffffu); yv[1] = bf2f(yw.x >> 16); yv[2] = bf2f(yw.y & 0xffffu); yv[3] = bf2f(yw.y >> 16);
            const f32x4 xn = xv + yv * rn * g4[j];
            if (out_final) *((f32x4*)(out_final + (size_t)r * DM) + lane + 64 * j) = xn;
            else { ss += (xn[0] * xn[0] + xn[1] * xn[1]) + (xn[2] * xn[2] + xn[3] * xn[3]);
                u32x2 w; w.x = pk2(xn[0], xn[1]); w.y = pk2(xn[2], xn[3]); *((u32x2*)(XB + (size_t)r * DM) + lane + 64 * j) = w; }
        }
        if (!out_final) { ss = wave_sum(ss); if (lane == 0) rsx[r] = rsqrtf(ss * (1.f / DM) + EPS); }
    }
}

DI void mixer_phase(unsigned char* ws, int l, LAS unsigned char* lds, int G) {
    const bf16* U = (const bf16*)(ws + WS_U); const bf16* VNT = (const bf16*)(ws + WS_VNT); const bf16* P = (const bf16*)(ws + WS_P);
    const bf16* Q = (const bf16*)(ws + WS_Q); const bf16* Kb = (const bf16*)(ws + WS_K); const bf16* VT = (const bf16*)(ws + WS_VT);
    bf16* MIX = (bf16*)(ws + WS_BUFA);
    const bf16* WMk = (const bf16*)(ws + WS_WM) + (size_t)l * 4 * 128 * 128; const bf16* PWT = (const bf16*)(ws + WS_PWT) + (size_t)l * 4 * 64 * 64;
    const float* par = (const float*)(ws + WS_PAR); const float* bs = par + PAR_BS + l * 512; const float* pscale = par + PAR_PSC + l * 256; const float* sinks = par + PAR_SNK + l * 8;
    const int tid = opaque_tid(), lane = tid & 63, wave = __builtin_amdgcn_readfirstlane(tid >> 6), c32 = lane & 31, h = lane >> 5;
    LAS unsigned char* Ks = lds; LAS unsigned char* Vs = lds + 36864;
    for (int blk = opaque_bid(); blk < M / 128; blk += G) {
        const int row0 = blk * 128, b = blk >> 5, nb = blk & 31;
        const int tt = wave >> 1, dtile = wave & 1;
#pragma unroll 1
        for (int g = 0; g < 4; ++g) {
            f32x16 acc;
#pragma unroll
            for (int i = 0; i < 16; ++i) acc[i] = 0.f;
            const bf16* Wrow = WMk + ((size_t)(g * 128 + 32 * tt + c32)) * 128 + 8 * h;
            const bf16* Vrow = VNT + ((size_t)(blk * 4 + g) * 64 + 32 * dtile + c32) * 128 + 8 * h;
            for (int ks = 0; ks <= 2 * tt + 1; ++ks) { const bf16x8 af = *(const bf16x8*)(Wrow + 16 * ks); const bf16x8 bfr = *(const bf16x8*)(Vrow + 16 * ks); acc = MFMA32(af, bfr, acc); }
            const int d = g * 64 + 32 * dtile + c32;
#pragma unroll
            for (int i = 0; i < 16; ++i) { const int t = 32 * tt + crow(i, h); const size_t r = (size_t)(row0 + t);
                const float mixed = acc[i] + bs[g * 128 + t]; const float uu = bf2f(U[r * 256 + d]);
                MIX[r * 1024 + d] = f2bf1(uu * mixed); }
        }
#pragma unroll 1
        for (int g = 0; g < 4; ++g) {
            const int w = 2 << g;
            f32x16 acc;
#pragma unroll
            for (int i = 0; i < 16; ++i) acc[i] = 0.f;
            const int t = 32 * tt + c32, tpos = nb * 128 + t; const int cnt = (tpos + 1 < w) ? (tpos + 1) : w; const float icnt = 1.f / (float)cnt;
#pragma unroll 1
            for (int ks = 0; ks < 4; ++ks) {
                const bf16* prow = P + (size_t)(row0 + t) * 256 + g * 64 + 16 * ks + 8 * h;
                float sum[8], own[8];
#pragma unroll
                for (int e = 0; e < 8; ++e) sum[e] = 0.f;
                for (int k = 0; k < cnt; ++k) { const u32x4 v = *(const u32x4*)(prow - (size_t)k * 256);
                    float f[8]; f[0] = bf2f(v.x & 0xffffu); f[1] = bf2f(v.x >> 16); f[2] = bf2f(v.y & 0xffffu); f[3] = bf2f(v.y >> 16); f[4] = bf2f(v.z & 0xffffu); f[5] = bf2f(v.z >> 16); f[6] = bf2f(v.w & 0xffffu); f[7] = bf2f(v.w >> 16);
#pragma unroll
                    for (int e = 0; e < 8; ++e) { sum[e] += f[e]; if (k == 0) own[e] = f[e]; } }
                u32x4 pa; pa.x = pk2(sum[0] * icnt - own[0], sum[1] * icnt - own[1]); pa.y = pk2(sum[2] * icnt - own[2], sum[3] * icnt - own[3]);
                pa.z = pk2(sum[4] * icnt - own[4], sum[5] * icnt - own[5]); pa.w = pk2(sum[6] * icnt - own[6], sum[7] * icnt - own[7]);
                const bf16x8 af = __builtin_bit_cast(bf16x8, pa);
                const bf16x8 bfr = *(const bf16x8*)(PWT + ((size_t)(g * 64 + 32 * dtile + c32)) * 64 + 16 * ks + 8 * h);
                acc = MFMA32(af, bfr, acc);
            }
            const int d = g * 64 + 32 * dtile + c32; const float psc = pscale[d];
#pragma unroll
            for (int i = 0; i < 16; ++i) { const size_t r = (size_t)(row0 + 32 * tt + crow(i, h)); MIX[r * 1024 + 256 + d] = f2bf1(acc[i] * psc); }
        }
#pragma unroll 1
        for (int hv = 0; hv < 2; ++hv) {
            __syncthreads();
#pragma unroll
            for (int it = 0; it < 4; ++it) { const int id = tid + NTHREADS * it;
                { const int kk = id >> 3, ch = id & 7; u32x4 v = {0u, 0u, 0u, 0u};
                  if (nb > 0 || kk >= 128) v = *(const u32x4*)(Kb + (size_t)(row0 - 128 + kk) * 128 + hv * 64 + ch * 8);
                  *(LAS u32x4*)(Ks + kk * 144 + ch * 16) = v; }
                { const int d = id >> 5, ch = id & 31; u32x4 v = {0u, 0u, 0u, 0u};
                  if (nb > 0 || ch >= 16) v = *(const u32x4*)(VT + ((size_t)((b * 2 + hv) * 32 + nb - 1 + (ch >> 4)) * 64 + d) * 128 + (ch & 15) * 8);
                  *(LAS u32x4*)(Vs + d * 528 + ch * 16) = v; } }
            __syncthreads();
#pragma unroll 1
            for (int it = 0; it < 2; ++it) {
                const int qh = wave & 3, sb = (wave >> 2) + 2 * it, head = 4 * hv + qh;
                const size_t r = (size_t)(row0 + 32 * sb + c32);
                bf16x8 qf[4];
#pragma unroll
                for (int st = 0; st < 4; ++st) qf[st] = *(const bf16x8*)(Q + r * 512 + head * 64 + 16 * st + 8 * h);
                f32x16 S[5];
#pragma unroll
                for (int kt = 0; kt < 5; ++kt) {
#pragma unroll
                    for (int i = 0; i < 16; ++i) S[kt][i] = 0.f;
#pragma unroll
                    for (int st = 0; st < 4; ++st) { const bf16x8 kf = *(const LAS bf16x8*)(Ks + (32 * (sb + kt) + c32) * 144 + (16 * st + 8 * h) * 2); S[kt] = MFMA32(kf, qf[st], S[kt]); }
                }
                const float sink = sinks[head] * LOG2E;
                float mx = sink;
#pragma unroll
                for (int kt = 0; kt < 5; ++kt)
#pragma unroll
                    for (int i = 0; i < 16; ++i) { const int krel = 32 * kt + crow(i, h);
                        const bool valid = (krel > c32) && (krel <= c32 + 128) && (nb > 0 || 32 * sb + krel >= 128);
                        const float sv = valid ? S[kt][i] : -INFINITY; S[kt][i] = sv; mx = fmaxf(mx, sv); }
                mx = fmaxf(mx, __shfl_xor(mx, 32));
                float sum = 0.f;
#pragma unroll
                for (int kt = 0; kt < 5; ++kt)
#pragma unroll
                    for (int i = 0; i < 16; ++i) { const float e = __builtin_amdgcn_exp2f(S[kt][i] - mx); S[kt][i] = e; sum += e; }
                sum += __shfl_xor(sum, 32); sum += __builtin_amdgcn_exp2f(sink - mx);
                const float inv = 1.f / sum;
                f32x16 O[2];
#pragma unroll
                for (int i = 0; i < 16; ++i) { O[0][i] = 0.f; O[1][i] = 0.f; }
#pragma unroll
                for (int kt = 0; kt < 5; ++kt)
#pragma unroll
                    for (int s = 0; s < 2; ++s) {
                        u32x4 pw; pw.x = pk2(S[kt][8 * s + 0], S[kt][8 * s + 1]); pw.y = pk2(S[kt][8 * s + 2], S[kt][8 * s + 3]); pw.z = pk2(S[kt][8 * s + 4], S[kt][8 * s + 5]); pw.w = pk2(S[kt][8 * s + 6], S[kt][8 * s + 7]);
                        const bf16x8 pf = __builtin_bit_cast(bf16x8, pw);
#pragma unroll
                        for (int dt = 0; dt < 2; ++dt) { const LAS unsigned char* vp = Vs + (32 * dt + c32) * 528 + (32 * (sb + kt) + 16 * s + 4 * h) * 2;
                            const u32x2 lo = *(const LAS u32x2*)vp, hi = *(const LAS u32x2*)(vp + 16);
                            u32x4 vv; vv.x = lo.x; vv.y = lo.y; vv.z = hi.x; vv.w = hi.y;
                            O[dt] = MFMA32(__builtin_bit_cast(bf16x8, vv), pf, O[dt]); }
                    }
#pragma unroll
                for (int dt = 0; dt < 2; ++dt)
#pragma unroll
                    for (int g4 = 0; g4 < 4; ++g4) { u32x2 w; w.x = pk2(O[dt][4 * g4] * inv, O[dt][4 * g4 + 1] * inv); w.y = pk2(O[dt][4 * g4 + 2] * inv, O[dt][4 * g4 + 3] * inv);
                        *(u32x2*)(MIX + r * 1024 + 512 + head * 64 + 32 * dt + 8 * g4 + 4 * h) = w; }
            }
        }
        __syncthreads();
    }
}

DI void xattn_phase(unsigned char* ws, int l, LAS unsigned char* lds, int G) {
    const bf16* QX = (const bf16*)(ws + WS_BUFA); bf16* OX = (bf16*)(ws + WS_U);
    const bf16* KM = (const bf16*)(ws + WS_KM) + (size_t)l * MMEM * DM; const bf16* VTM = (const bf16*)(ws + WS_VTM) + (size_t)l * MMEM * DM;
    const int tid = opaque_tid(), lane = tid & 63, wave = __builtin_amdgcn_readfirstlane(tid >> 6), c32 = lane & 31, h = lane >> 5;
    for (int item = opaque_bid(); item < NBATCH * 4 * 16; item += G) {
        const int qc = item & 15, head = (item >> 4) & 3, b = item >> 6;
        __syncthreads();
#pragma unroll 4
        for (int it = 0; it < 16; ++it) { const int id = tid + NTHREADS * it, mrow = id >> 5, ch = id & 31;
            *(LAS u32x4*)(lds + mrow * 528 + ch * 16) = *(const u32x4*)(KM + (size_t)(b * 256 + mrow) * 1024 + head * 256 + ch * 8); }
        __syncthreads();
        const size_t r = (size_t)b * SEQ + qc * 256 + 32 * wave + c32;
        f32x16 S[8];
#pragma unroll
        for (int mt = 0; mt < 8; ++mt)
#pragma unroll
            for (int i = 0; i < 16; ++i) S[mt][i] = 0.f;
#pragma unroll 2
        for (int st = 0; st < 16; ++st) { const bf16x8 qf = *(const bf16x8*)(QX + r * 1024 + head * 256 + 16 * st + 8 * h);
#pragma unroll
            for (int mt = 0; mt < 8; ++mt) { const bf16x8 kf = *(const LAS bf16x8*)(lds + (32 * mt + c32) * 528 + (16 * st + 8 * h) * 2); S[mt] = MFMA32(kf, qf, S[mt]); } }
        float mx = -INFINITY;
#pragma unroll
        for (int mt = 0; mt < 8; ++mt)
#pragma unroll
            for (int i = 0; i < 16; ++i) mx = fmaxf(mx, S[mt][i]);
        mx = fmaxf(mx, __shfl_xor(mx, 32));
        float sum = 0.f; bf16x8 pf[8][2];
#pragma unroll
        for (int mt = 0; mt < 8; ++mt) {
#pragma unroll
            for (int i = 0; i < 16; ++i) { const float e = __builtin_amdgcn_exp2f(S[mt][i] - mx); S[mt][i] = e; sum += e; }
#pragma unroll
            for (int s = 0; s < 2; ++s) { u32x4 pw; pw.x = pk2(S[mt][8 * s + 0], S[mt][8 * s + 1]); pw.y = pk2(S[mt][8 * s + 2], S[mt][8 * s + 3]); pw.z = pk2(S[mt][8 * s + 4], S[mt][8 * s + 5]); pw.w = pk2(S[mt][8 * s + 6], S[mt][8 * s + 7]);
                pf[mt][s] = __builtin_bit_cast(bf16x8, pw); }
        }
        sum += __shfl_xor(sum, 32);
        const float inv = 1.f / sum;
        __syncthreads();
#pragma unroll 4
        for (int it = 0; it < 16; ++it) { const int id = tid + NTHREADS * it, d = id >> 5, ch = id & 31;
            *(LAS u32x4*)(lds + d * 528 + ch * 16) = *(const u32x4*)(VTM + ((size_t)(b * 4 + head) * 256 + d) * 256 + ch * 8); }
        __syncthreads();
#pragma unroll 1
        for (int dt = 0; dt < 8; ++dt) {
            f32x16 O;
#pragma unroll
            for (int i = 0; i < 16; ++i) O[i] = 0.f;
#pragma unroll
            for (int mt = 0; mt < 8; ++mt)
#pragma unroll
                for (int s = 0; s < 2; ++s) { const LAS unsigned char* vp = lds + (32 * dt + c32) * 528 + (32 * mt + 16 * s + 4 * h) * 2;
                    const u32x2 lo = *(const LAS u32x2*)vp, hi = *(const LAS u32x2*)(vp + 16);
                    u32x4 vv; vv.x = lo.x; vv.y = lo.y; vv.z = hi.x; vv.w = hi.y;
                    O = MFMA32(__builtin_bit_cast(bf16x8, vv), pf[mt][s], O); }
#pragma unroll
            for (int g4 = 0; g4 < 4; ++g4) { u32x2 w; w.x = pk2(O[4 * g4] * inv, O[4 * g4 + 1] * inv); w.y = pk2(O[4 * g4 + 2] * inv, O[4 * g4 + 3] * inv);
                *(u32x2*)(OX + r * 1024 + head * 256 + 32 * dt + 8 * g4 + 4 * h) = w; }
        }
    }
    __syncthreads();
}

#define XB_TMO      128
#define XB_XCNT(j)  (256  + 64 * (j))
#define XB_XSUB(j)  (1280 + 64 * (j))
#define XB_XGEN(j)  (2304 + 64 * (j))
#define XB_TOP      3328
#define XB_TOPGEN   3392
#define XCD_BAR_WORDS 3456
#define XB_SPIN_CAP (1u << 18)

__device__ __forceinline__ unsigned xb_ld(unsigned* p)              { return __hip_atomic_load(p, __ATOMIC_RELAXED, __HIP_MEMORY_SCOPE_AGENT); }
__device__ __forceinline__ unsigned xb_add(unsigned* p, unsigned v) { return __hip_atomic_fetch_add(p, v, __ATOMIC_RELAXED, __HIP_MEMORY_SCOPE_AGENT); }
__device__ __forceinline__ unsigned xb_xcc_id() { return (unsigned)__builtin_amdgcn_s_getreg((3 << 11) | 20) & 0xFu; }
#define XB_SPIN(cond, bar) do { unsigned _sp = 0; while (cond) { __builtin_amdgcn_s_sleep(1); \
    if ((++_sp & 255u) == 0u) { if (xb_ld(&(bar)[XB_TMO])) break; if (_sp > XB_SPIN_CAP) { atomicAdd(&(bar)[XB_TMO], 1u); break; } } } } while (0)

struct XcdBarrier {
    unsigned* bar; unsigned x;
    volatile LAS unsigned* st;
};

__device__ __forceinline__ XcdBarrier xcd_barrier_post(unsigned* bar, volatile LAS unsigned* st) {
    XcdBarrier b; b.bar = bar; b.x = xb_xcc_id(); b.st = st;
    if (threadIdx.x == 0) (void)xb_add(&bar[XB_XCNT(b.x)], 1u);
    return b;
}
__device__ __forceinline__ void xcd_barrier_complete(unsigned* bar, unsigned x, unsigned& nloc, unsigned& nx) {
    const unsigned G = gridDim.x * gridDim.y * gridDim.z;
    unsigned sum, cnt, mine, sp = 0u;
    for (;;) {
        sum = 0u; cnt = 0u; mine = 0u;
#pragma unroll
        for (unsigned j = 0; j < 16; ++j) { const unsigned c = xb_ld(&bar[XB_XCNT(j)]); sum += c; cnt += (c > 0u) ? 1u : 0u; mine = (j == x) ? c : mine; }
        if (sum == G) break;
        __builtin_amdgcn_s_sleep(1);
        if ((++sp & 255u) == 0u) { if (xb_ld(&bar[XB_TMO])) break; if (sp > XB_SPIN_CAP) { atomicAdd(&bar[XB_TMO], 1u); break; } }
    }
    nloc = mine > 0u ? mine : 1u; nx = cnt > 0u ? cnt : 1u;
}

__device__ __forceinline__ void xcd_barrier(const XcdBarrier& b) {
    asm volatile("s_waitcnt vmcnt(0)" ::: "memory");
    __syncthreads();
    if (threadIdx.x == 0) {
        unsigned* bar = b.bar;
        __builtin_amdgcn_s_waitcnt(0);
        unsigned nloc = b.st[0], nx = b.st[1];
        if (nloc == 0u) { xcd_barrier_complete(bar, b.x, nloc, nx); b.st[0] = nloc; b.st[1] = nx; }
        const unsigned old = xb_add(&bar[XB_XSUB(b.x)], 1u);
        const unsigned gen = old / nloc;
        if (old + 1u == (gen + 1u) * nloc) {
            __builtin_amdgcn_fence(__ATOMIC_RELEASE, "agent");
            asm volatile("s_waitcnt vmcnt(0)" ::: "memory");
            const unsigned og = xb_add(&bar[XB_TOP], 1u);
            const unsigned tg = og / nx;
            if (og + 1u == (tg + 1u) * nx) xb_add(&bar[XB_TOPGEN], 1u);
            else XB_SPIN(xb_ld(&bar[XB_TOPGEN]) == tg, bar);
            __builtin_amdgcn_fence(__ATOMIC_ACQUIRE, "agent");
            xb_add(&bar[XB_XGEN(b.x)], 1u);
            asm volatile("s_waitcnt vmcnt(0)" ::: "memory");
        } else {
            XB_SPIN(xb_ld(&bar[XB_XGEN(b.x)]) == gen, bar);
            __builtin_amdgcn_fence(__ATOMIC_ACQUIRE, "agent");
            asm volatile("s_waitcnt vmcnt(0)" ::: "memory");
        }
    }
    __syncthreads();
}

#ifndef PG8_SP2
#define PG8_SP2 true
#endif
#ifndef PG8_ALIGN
#define PG8_ALIGN true
#endif
constexpr int N_PHASES = 2 + 11 * DEPTH;
#ifndef MK_DUP
#define MK_DUP -1
#endif
#define DUPN(k) ((MK_DUP == (k)) ? 2 : 1)

__global__ void __launch_bounds__(NTHREADS, 2) mk_fwd(Args a) {
    extern __shared__ __attribute__((aligned(16))) unsigned char lds_raw[];
    LAS unsigned char* lds = (LAS unsigned char*)lds_raw;
    cg::grid_group grid = cg::this_grid();
    const int G = gridDim.x, lo = a.ph_lo, hi = a.ph_hi;
    unsigned char* ws = a.ws;
    volatile LAS unsigned* bst = (volatile LAS unsigned*)(lds + LDS_BYTES - 64);
    unsigned* barw = (unsigned*)(ws + WS_BAR);
    XcdBarrier bar; bar.bar = barw; bar.x = 0; bar.st = bst;
    if (hi - lo > 1) {
        if (threadIdx.x < 2) bst[threadIdx.x] = 0u;
        if (blockIdx.x == 0) for (int i = threadIdx.x; i < XCD_BAR_WORDS; i += NTHREADS) __hip_atomic_store(barw + i, 0u, __ATOMIC_RELAXED, __HIP_MEMORY_SCOPE_AGENT);
        grid.sync();
        bar = xcd_barrier_post(barw, bst);
    }
#define IN(k) (lo <= (k) && (k) < hi)
#define SEAM(k) do { if (IN((k) + 1)) xcd_barrier(bar); } while (0)
    if (IN(0)) { prologue(a, lds, G); SEAM(0); }
    if (IN(1)) {
        pg8::Gemm g{(const pg8::bf16_t*)(ws + WS_MEMN), (const pg8::bf16_t*)(ws + WS_WXKV), MMEM, DEPTH * 2 * DM, DM}; pg8::StaticOrder S; S.init(MMEM, DEPTH * 2 * DM, G, opaque_bid());
        pg8::EpiKV E{ws};
        pg8::gemm_phase<pg8::EpiKV, pg8::StaticOrder, false, PG8_SP2>(lds, g, S, E);
        SEAM(1);
    }
#pragma unroll 1
    for (int l = 0; l < DEPTH; ++l) {
        const int p0 = 2 + 11 * l;
        if (IN(p0 + 0)) {
            pg8::Gemm g{(const pg8::bf16_t*)(ws + WS_XB), (const pg8::bf16_t*)(ws + WS_WIN) + (size_t)l * D_IN * DM, M, D_IN, DM}; pg8::StaticOrder S; S.init(M, D_IN, G, opaque_bid());
            pg8::EpiIn E{ws, l};
            for (int rep_ = 0; rep_ < DUPN(0); ++rep_) pg8::gemm_phase<pg8::EpiIn, pg8::StaticOrder, PG8_ALIGN, PG8_SP2>(lds, g, S, E);
            SEAM(p0 + 0);
        }
        if (IN(p0 + 1)) { for (int rep_ = 0; rep_ < DUPN(1); ++rep_) mixer_phase(ws, l, lds, G); SEAM(p0 + 1); }
        if (IN(p0 + 2)) {
            pg8::Gemm g{(const pg8::bf16_t*)(ws + WS_BUFA), (const pg8::bf16_t*)(ws + WS_WO) + (size_t)l * DM * DM, M, DM, DM}; pg8::StaticOrder S; S.init(M, DM, G, opaque_bid());
            pg8::EpiY E{ws};
            for (int rep_ = 0; rep_ < DUPN(2); ++rep_) pg8::gemm_phase<pg8::EpiY, pg8::StaticOrder, PG8_ALIGN, PG8_SP2>(lds, g, S, E);
            SEAM(p0 + 2);
        }
        if (IN(p0 + 3)) { res_phase(nullptr, ws, l * 3 + 0, G); SEAM(p0 + 3); }
        if (IN(p0 + 4)) {
            pg8::Gemm g{(const pg8::bf16_t*)(ws + WS_XB), (const pg8::bf16_t*)(ws + WS_WXQ) + (size_t)l * DM * DM, M, DM, DM}; pg8::StaticOrder S; S.init(M, DM, G, opaque_bid());
            pg8::EpiQx E{ws};
            for (int rep_ = 0; rep_ < DUPN(4); ++rep_) pg8::gemm_phase<pg8::EpiQx, pg8::StaticOrder, PG8_ALIGN, PG8_SP2>(lds, g, S, E);
            SEAM(p0 + 4);
        }
        if (IN(p0 + 5)) { for (int rep_ = 0; rep_ < DUPN(5); ++rep_) xattn_phase(ws, l, lds, G); SEAM(p0 + 5); }
        if (IN(p0 + 6)) {
            pg8::Gemm g{(const pg8::bf16_t*)(ws + WS_U), (const pg8::bf16_t*)(ws + WS_WXO) + (size_t)l * DM * DM, M, DM, DM}; pg8::StaticOrder S; S.init(M, DM, G, opaque_bid());
            pg8::EpiY E{ws};
            for (int rep_ = 0; rep_ < DUPN(6); ++rep_) pg8::gemm_phase<pg8::EpiY, pg8::StaticOrder, PG8_ALIGN, PG8_SP2>(lds, g, S, E);
            SEAM(p0 + 6);
        }
        if (IN(p0 + 7)) { res_phase(nullptr, ws, l * 3 + 1, G); SEAM(p0 + 7); }
        if (IN(p0 + 8)) {
            pg8::Gemm g{(const pg8::bf16_t*)(ws + WS_XB), (const pg8::bf16_t*)(ws + WS_WGU) + (size_t)l * 2 * D_FF * DM, M, 2 * D_FF, DM}; pg8::StaticOrder S; S.init(M, 2 * D_FF, G, opaque_bid());
            pg8::EpiGU E{ws};
            for (int rep_ = 0; rep_ < DUPN(8); ++rep_) pg8::gemm_phase<pg8::EpiGU, pg8::StaticOrder, PG8_ALIGN, PG8_SP2>(lds, g, S, E);
            SEAM(p0 + 8);
        }
        if (IN(p0 + 9)) {
            pg8::Gemm g{(const pg8::bf16_t*)(ws + WS_F), (const pg8::bf16_t*)(ws + WS_WDN) + (size_t)l * DM * D_FF, M, DM, D_FF}; pg8::StaticOrder S; S.init(M, DM, G, opaque_bid());
            pg8::EpiY E{ws};
            for (int rep_ = 0; rep_ < DUPN(9); ++rep_) pg8::gemm_phase<pg8::EpiY, pg8::StaticOrder, PG8_ALIGN, PG8_SP2>(lds, g, S, E);
            SEAM(p0 + 9);
        }
        if (IN(p0 + 10)) { res_phase(l == DEPTH - 1 ? a.out : nullptr, ws, l * 3 + 2, G); SEAM(p0 + 10); }
    }
#undef IN
#undef SEAM
}

extern "C" void kernel_launch(void* const* d_in, const int* in_sizes, int n_in, void* d_out, int out_size, void* d_ws, size_t ws_size, hipStream_t stream) {
    static int grid = 0;
    if (grid == 0) {
        if (n_in != 23 || in_sizes[0] != M * DM || out_size != M * DM || ws_size < WS_END) { fprintf(stderr, "kernel_launch: unexpected shapes (n_in %d, in0 %d, out %d, ws %zu < %zu)\n", n_in, n_in > 0 ? in_sizes[0] : -1, out_size, ws_size, (size_t)WS_END); grid = -1; return; }
        int dev = 0, cus = 0, per_cu = 0;
        (void)hipGetDevice(&dev); (void)hipDeviceGetAttribute(&cus, hipDeviceAttributeMultiprocessorCount, dev);
        if (hipFuncSetAttribute((const void*)mk_fwd, hipFuncAttributeMaxDynamicSharedMemorySize, LDS_BYTES) != hipSuccess) fprintf(stderr, "kernel_launch: hipFuncSetAttribute failed\n");
        if (hipOccupancyMaxActiveBlocksPerMultiprocessor(&per_cu, (const void*)mk_fwd, NTHREADS, LDS_BYTES) != hipSuccess || per_cu < 1) { fprintf(stderr, "kernel_launch: occupancy query says %d; using 1 per CU\n", per_cu); per_cu = 1; }
        (void)hipGetLastError();
        grid = cus * per_cu; if (grid <= 0) grid = 256;
    }
    if (grid < 0) return;
    Args a{};
    for (int i = 0; i < 23; ++i) a.in[i] = d_in[i];
    a.out = (float*)d_out; a.ws = (unsigned char*)d_ws;
#if MK_PER_PHASE
    for (int ph = 0; ph < N_PHASES; ++ph) { a.ph_lo = ph; a.ph_hi = ph + 1; hipLaunchKernelGGL(mk_fwd, dim3(grid), dim3(NTHREADS), LDS_BYTES, stream, a); }
#else
    a.ph_lo = 0; a.ph_hi = N_PHASES;
    void* args[] = {&a};
    const hipError_t e = hipLaunchCooperativeKernel((const void*)mk_fwd, dim3(grid), dim3(NTHREADS), args, LDS_BYTES, stream);
    if (e != hipSuccess) fprintf(stderr, "kernel_launch: cooperative launch failed: %s (grid %d)\n", hipGetErrorString(e), grid);
#endif
}
```

```cpp
#include <hip/hip_runtime.h>
#include <hip/hip_cooperative_groups.h>
#include <cstdio>
#include <cstdint>
namespace cg = cooperative_groups;

#ifndef MK_PER_PHASE
#define MK_PER_PHASE 0
#endif

typedef __attribute__((address_space(3))) unsigned char lds_u8;
constexpr int DM = 1024, NBATCH = 8, SEQ = 4096, DEPTH = 4, MEML = 256, M = NBATCH * SEQ, MMEM = NBATCH * MEML, D_IN = 1536, D_FF = 2816;
constexpr float EPS = 1e-6f, LOG2E = 1.4426950408889634f;
constexpr int NWAVES = 8, NTHREADS = 512;
constexpr int LDS_BYTES = 147456;
constexpr size_t MiB = 1u << 20;
constexpr size_t WS_WIN = 0, WS_WO = 12 * MiB, WS_WXQ = 20 * MiB, WS_WXO = 28 * MiB, WS_WGU = 36 * MiB, WS_WDN = 80 * MiB, WS_WXKV = 102 * MiB;
constexpr size_t WS_WM = 118 * MiB, WS_PWT = WS_WM + 512 * 1024, WS_RS = WS_PWT + 128 * 1024, WS_YSQ = 468 * MiB;
constexpr size_t WS_PAR = WS_RS + 128 * 1024, PAR_VG = 0, PAR_BS = 1024, PAR_PSC = 3072, PAR_SNK = 4096, PAR_GPOST = 4160;
constexpr size_t WS_COS = 120 * MiB, WS_SIN = 124 * MiB, WS_KM = 128 * MiB, WS_VTM = 144 * MiB, WS_MEMN = 160 * MiB, WS_XB = 164 * MiB, WS_Y = 228 * MiB, WS_R = 292 * MiB;
constexpr size_t WS_U = WS_R, WS_VNT = WS_R + 16 * MiB, WS_P = WS_R + 32 * MiB, WS_Q = WS_R + 48 * MiB, WS_K = WS_R + 80 * MiB, WS_VT = WS_R + 88 * MiB, WS_BUFA = WS_R + 96 * MiB, WS_F = WS_R;
constexpr size_t WS_BAR = WS_YSQ + 2 * MiB;
constexpr size_t WS_END = WS_BAR + 1 * MiB;
static_assert(WS_YSQ == WS_R + 176 * MiB && WS_PAR + (PAR_GPOST + DEPTH * 3 * DM) * 4 <= WS_COS, "ws map");
static_assert((size_t)M * D_FF * 2 <= 176 * MiB, "f fits");


namespace pg8 {
#define PG8_LAS __attribute__((address_space(3)))
typedef unsigned short bf16_t;
typedef short bf16x8 __attribute__((ext_vector_type(8)));
typedef float f32x4 __attribute__((ext_vector_type(4)));
typedef unsigned u32x4 __attribute__((ext_vector_type(4)));
constexpr int BM = 256, BK = 64, HALF = 128, HTB = HALF * BK * 2  , STAGE_BYTES = 8 * HTB, NXCD = 8, WGM = 8;

__host__ __device__ __forceinline__ int lds_byte(int r, int c) { const int st = (r >> 4) * 2 + (c >> 5), rr = r & 15, cc = c & 31, ob = rr * 64 + cc * 2; return st * 1024 + (ob ^ (((ob >> 9) & 1) << 5)); }
__host__ __device__ __forceinline__ void stage_rc(int b, int& R, int& C) { const int st = b / 1024, sb = b % 1024, swz = sb ^ (((sb >> 9) & 1) << 5); R = (st >> 1) * 16 + swz / 64; C = (st & 1) * 32 + (swz % 64) / 2; }
__host__ __device__ __forceinline__ int perm32(int rho) { const int n = rho >> 4, i = rho & 15; return 8 * (i >> 2) + 4 * n + (i & 3); }

struct Unit { int pm, pn; };
struct Gemm { const bf16_t* A; const bf16_t* Bt; int M, N, K; };

struct StaticOrder {
    int nM, nN, nwg, G, c;
    __host__ __device__ void init(int M, int N, int G_, int c_) { nM = M / BM; nN = N / BM; nwg = nM * nN; G = G_; c = c_; }
    __host__ __device__ bool next(int i, Unit& u) const {
        const long L = (long)i * G + c; if (L >= nwg) return false;
        int wgid = (int)L; { const int q = nwg / NXCD, r = nwg % NXCD, xcd = wgid % NXCD, off = wgid / NXCD; wgid = (xcd < r ? xcd * (q + 1) : r * (q + 1) + (xcd - r) * q) + off; }
        const int nig = WGM * nN, gid = wgid / nig, fm = gid * WGM, gsz = (nM - fm) < WGM ? (nM - fm) : WGM;
        u.pm = fm + ((wgid % nig) % gsz); u.pn = (wgid % nig) / gsz; return true;
    }
    __device__ __forceinline__ void a_ready(const Unit&) const {}
    __device__ __forceinline__ void done(const Unit&) const {}
};


typedef unsigned u32x2 __attribute__((ext_vector_type(2)));
typedef float f32x2 __attribute__((ext_vector_type(2)));
typedef __bf16 bf16v2 __attribute__((ext_vector_type(2)));
__device__ __forceinline__ unsigned pk2(float lo, float hi) { f32x2 v = {lo, hi}; bf16v2 b = __builtin_convertvector(v, bf16v2); return __builtin_bit_cast(unsigned, b); }
__device__ __forceinline__ bf16_t f2bf1(float v) { return (bf16_t)(pk2(v, 0.f) & 0xffffu); }
__device__ __forceinline__ u32x4 pk8(const f32x4 a, const f32x4 b) { u32x4 w; w.x = pk2(a[0], a[1]); w.y = pk2(a[2], a[3]); w.z = pk2(b[0], b[1]); w.w = pk2(b[2], b[3]); return w; }
__device__ __forceinline__ float gelu_tanh(float x) {
    const float u = x * (1.f + 0.044715f * x * x);
    const float e = __builtin_amdgcn_exp2f(u * (-2.f * 0.7978845608028654f * 1.4426950408889634f));
    return x * __builtin_amdgcn_rcpf(1.f + e);
}
__device__ __forceinline__ float silu_f(float x) { return x * __builtin_amdgcn_rcpf(1.f + __builtin_amdgcn_exp2f(x * -1.4426950408889634f)); }
constexpr float NORM_EPS = 1e-6f;
constexpr float QSCALE_SWA = 0.125f * 1.4426950408889634f;
constexpr float QSCALE_X = 0.0625f * 1.4426950408889634f;

struct EpiIn {
    static constexpr bool PERM = true, AFTER_DRAIN = false;
    unsigned char* ws; int l;
    __device__ __forceinline__ void operator()(const f32x4 (&acc)[2][2][4][2], const Unit& u, int wr, int wc, int fr, int fq) const {
        asm volatile("" : "+v"(fr), "+v"(fq), "+s"(wr), "+s"(wc));
        const float* rs = (const float*)(ws + WS_RS); bf16_t* U = (bf16_t*)(ws + WS_U); bf16_t* VNT = (bf16_t*)(ws + WS_VNT); bf16_t* P = (bf16_t*)(ws + WS_P); bf16_t* Q = (bf16_t*)(ws + WS_Q);
        bf16_t* Kb = (bf16_t*)(ws + WS_K); bf16_t* VT = (bf16_t*)(ws + WS_VT); const float* vgain = (const float*)(ws + WS_PAR) + PAR_VG + l * 256;
        const float* cosT = (const float*)(ws + WS_COS); const float* sinT = (const float*)(ws + WS_SIN);
        const int pn = u.pn;
        const int rbase = u.pm * BM + wr * 64 + fr;
        if (pn == 0 || pn == 2) {
            bf16_t* O = (pn == 0) ? U : P;
#pragma unroll
            for (int ai = 0; ai < 2; ++ai)
#pragma unroll
                for (int m = 0; m < 4; ++m) { const int r = rbase + ai * HALF + m * 16; const float s = rs[r];
#pragma unroll
                    for (int bj = 0; bj < 2; ++bj) { f32x4 v0 = acc[ai][bj][m][0] * s, v1 = acc[ai][bj][m][1] * s;
                        if (pn == 0) {
#pragma unroll
                            for (int j = 0; j < 4; ++j) { v0[j] = gelu_tanh(v0[j]); v1[j] = gelu_tanh(v1[j]); } }
                        *(u32x4*)(O + (size_t)r * 256 + bj * HALF + wc * 32 + fq * 8) = pk8(v0, v1); } asm volatile("" ::: "memory"); }
        } else if (pn == 1) {
            const int g = wc;
#pragma unroll
            for (int ai = 0; ai < 2; ++ai)
#pragma unroll
                for (int m = 0; m < 4; ++m) { const int r = rbase + ai * HALF + m * 16; const float s = rs[r];
                    float v[2][2][4]; float ss = 0.f;
#pragma unroll
                    for (int bj = 0; bj < 2; ++bj)
#pragma unroll
                        for (int n = 0; n < 2; ++n)
#pragma unroll
                            for (int j = 0; j < 4; ++j) { const float t = gelu_tanh(acc[ai][bj][m][n][j] * s); v[bj][n][j] = t; ss += t * t; }
                    ss += __shfl_xor(ss, 16); ss += __shfl_xor(ss, 32);
                    const float rn = rsqrtf(ss * (1.f / 64.f) + NORM_EPS);
                    const int chunk = r >> 7, sidx = r & 127;
                    bf16_t* base = VNT + ((size_t)(chunk * 4 + g) * 64) * 128 + sidx;
#pragma unroll
                    for (int bj = 0; bj < 2; ++bj)
#pragma unroll
                        for (int n = 0; n < 2; ++n)
#pragma unroll
                            for (int j = 0; j < 4; ++j) { const int dd = 32 * bj + 8 * fq + 4 * n + j;
                                base[(size_t)dd * 128] = f2bf1(v[bj][n][j] * rn * vgain[g * 64 + dd]); } asm volatile("" ::: "memory"); }
        } else {
            const int ii = 4 * (wc & 1) + fq;
#pragma unroll
            for (int ai = 0; ai < 2; ++ai)
#pragma unroll
                for (int m = 0; m < 4; ++m) { const int r = rbase + ai * HALF + m * 16; const float s = rs[r];
                    const f32x4 c4 = *(const f32x4*)(cosT + (size_t)r * 32 + 4 * ii), s4 = *(const f32x4*)(sinT + (size_t)r * 32 + 4 * ii);
#pragma unroll
                    for (int bj = 0; bj < 2; ++bj) {
                        if (pn == 5 && bj == 1) {
                            const int hv = wc >> 1, b = r >> 12, nblk = (r >> 7) & 31;
                            bf16_t* base = VT + ((size_t)((b * 2 + hv) * 32 + nblk) * 64 + 32 * (wc & 1) + 8 * fq) * 128 + (r & 127);
#pragma unroll
                            for (int n = 0; n < 2; ++n)
#pragma unroll
                                for (int j = 0; j < 4; ++j) base[(4 * n + j) * 128] = f2bf1(acc[ai][bj][m][n][j] * s);
                        } else {
                            const float sc = (pn == 5) ? s : s * QSCALE_SWA;
                            const f32x4 x1 = acc[ai][bj][m][0] * sc, x2 = acc[ai][bj][m][1] * sc;
                            const f32x4 o1 = x1 * c4 - x2 * s4, o2 = x2 * c4 + x1 * s4;
                            bf16_t* dst = (pn == 5) ? (Kb + (size_t)r * 128 + wc * 32 + fq * 8) : (Q + (size_t)r * 512 + (pn - 3) * 256 + bj * HALF + wc * 32 + fq * 8);
                            *(u32x4*)dst = pk8(o1, o2);
                        } } asm volatile("" ::: "memory"); }
        }
    }
};

struct EpiY {
    static constexpr bool PERM = true, AFTER_DRAIN = false;
    unsigned char* ws;
    __device__ __forceinline__ void operator()(const f32x4 (&acc)[2][2][4][2], const Unit& u, int wr, int wc, int fr, int fq) const {
        asm volatile("" : "+v"(fr), "+v"(fq), "+s"(wr), "+s"(wc));
        bf16_t* Y = (bf16_t*)(ws + WS_Y); float* ysq = (float*)(ws + WS_YSQ);
        const int rbase = u.pm * BM + wr * 64 + fr, cbase = u.pn * BM + wc * 32 + fq * 8;
#pragma unroll
        for (int ai = 0; ai < 2; ++ai)
#pragma unroll
            for (int m = 0; m < 4; ++m) { const int r = rbase + ai * HALF + m * 16; float ss = 0.f;
#pragma unroll
                for (int bj = 0; bj < 2; ++bj) { const f32x4 v0 = acc[ai][bj][m][0], v1 = acc[ai][bj][m][1];
                    ss += (v0[0] * v0[0] + v0[1] * v0[1]) + (v0[2] * v0[2] + v0[3] * v0[3]) + (v1[0] * v1[0] + v1[1] * v1[1]) + (v1[2] * v1[2] + v1[3] * v1[3]);
                    *(u32x4*)(Y + (size_t)r * 1024 + cbase + bj * HALF) = pk8(v0, v1); }
                ss += __shfl_xor(ss, 16); ss += __shfl_xor(ss, 32);
                if (fq == 0) ysq[(size_t)r * 16 + u.pn * 4 + wc] = ss; asm volatile("" ::: "memory"); }
    }
};

struct EpiQx {
    static constexpr bool PERM = true, AFTER_DRAIN = false;
    unsigned char* ws;
    __device__ __forceinline__ void operator()(const f32x4 (&acc)[2][2][4][2], const Unit& u, int wr, int wc, int fr, int fq) const {
        asm volatile("" : "+v"(fr), "+v"(fq), "+s"(wr), "+s"(wc));
        const float* rs = (const float*)(ws + WS_RS); bf16_t* O = (bf16_t*)(ws + WS_BUFA);
        const int rbase = u.pm * BM + wr * 64 + fr, cbase = u.pn * BM + wc * 32 + fq * 8;
#pragma unroll
        for (int ai = 0; ai < 2; ++ai)
#pragma unroll
            for (int m = 0; m < 4; ++m) { const int r = rbase + ai * HALF + m * 16; const float s = rs[r] * QSCALE_X;
#pragma unroll
                for (int bj = 0; bj < 2; ++bj) *(u32x4*)(O + (size_t)r * 1024 + cbase + bj * HALF) = pk8(acc[ai][bj][m][0] * s, acc[ai][bj][m][1] * s); }
    }
};

struct EpiKV {
    static constexpr bool PERM = true, AFTER_DRAIN = false;
    unsigned char* ws;
    __device__ __forceinline__ void operator()(const f32x4 (&acc)[2][2][4][2], const Unit& u, int wr, int wc, int fr, int fq) const {
        asm volatile("" : "+v"(fr), "+v"(fq), "+s"(wr), "+s"(wc));
        bf16_t* KM = (bf16_t*)(ws + WS_KM); bf16_t* VTM = (bf16_t*)(ws + WS_VTM);
        const int layer = u.pn >> 3, t = u.pn & 7;
        const int rbase = u.pm * BM + wr * 64 + fr;
#pragma unroll
        for (int ai = 0; ai < 2; ++ai)
#pragma unroll
            for (int m = 0; m < 4; ++m) { const int r = rbase + ai * HALF + m * 16;
#pragma unroll
                for (int bj = 0; bj < 2; ++bj) {
                    if (t < 4) *(u32x4*)(KM + ((size_t)layer * 2048 + r) * 1024 + t * 256 + bj * HALF + wc * 32 + fq * 8) = pk8(acc[ai][bj][m][0], acc[ai][bj][m][1]);
                    else { const int b = r >> 8, mm = r & 255, head = t - 4;
                        bf16_t* base = VTM + ((size_t)((layer * 8 + b) * 4 + head) * 256) * 256 + mm;
#pragma unroll
                        for (int n = 0; n < 2; ++n)
#pragma unroll
                            for (int j = 0; j < 4; ++j) { const int d = bj * HALF + wc * 32 + fq * 8 + 4 * n + j; base[(size_t)d * 256] = f2bf1(acc[ai][bj][m][n][j]); } } } }
    }
};

struct EpiGU {
    static constexpr bool PERM = true, AFTER_DRAIN = false;
    unsigned char* ws;
    __device__ __forceinline__ void operator()(const f32x4 (&acc)[2][2][4][2], const Unit& u, int wr, int wc, int fr, int fq) const {
        asm volatile("" : "+v"(fr), "+v"(fq), "+s"(wr), "+s"(wc));
        const float* rs = (const float*)(ws + WS_RS); bf16_t* F = (bf16_t*)(ws + WS_F);
        const int rbase = u.pm * BM + wr * 64 + fr, cbase = u.pn * 128 + wc * 16 + fq * 4;
#pragma unroll
        for (int ai = 0; ai < 2; ++ai)
#pragma unroll
            for (int m = 0; m < 4; ++m) { const int r = rbase + ai * HALF + m * 16; const float s = rs[r];
#pragma unroll
                for (int bj = 0; bj < 2; ++bj) { const f32x4 g = acc[ai][bj][m][0] * s, up = acc[ai][bj][m][1] * s;
                    u32x2 w; w.x = pk2(silu_f(g[0]) * up[0], silu_f(g[1]) * up[1]); w.y = pk2(silu_f(g[2]) * up[2], silu_f(g[3]) * up[3]);
                    *(u32x2*)(F + (size_t)r * 2816 + cbase + bj * 64) = w; } }
    }
};

template <class Epi, class Sched, bool ALIGN_EPI = false, bool SP2 = false>
__device__ __forceinline__ void gemm_phase(PG8_LAS unsigned char* lds, const Gemm g, const Sched& S, const Epi& E) {
    int tid_ = threadIdx.x; asm volatile("" : "+v"(tid_));
    const int tid = tid_, wid = __builtin_amdgcn_readfirstlane(tid >> 6), lane = tid & 63, wr = wid >> 2, wc = wid & 3, fr = lane & 15, fq = lane >> 4;
    const int K = g.K, nt = K / BK;
    unsigned voffA[2], voffB[2];
#pragma unroll
    for (int i = 0; i < 2; ++i) { int R, C; stage_rc(tid * 16 + i * 8192, R, C); const int Rb = Epi::PERM ? ((R & ~31) + perm32(R & 31)) : R;
        voffA[i] = (unsigned)(R * K + C) * 2u; voffB[i] = (unsigned)(Rb * K + C) * 2u; }
    const size_t kstep = (size_t)(BK * 2);
    const size_t hstep = (size_t)HALF * K * 2;
    const size_t tstep = 2 * hstep;
    const unsigned ldsw = (unsigned)wid * 1024u;
    const int aoff = lds_byte(wr * 64 + fr, fq * 8), boff = lds_byte(wc * 32 + fr, fq * 8);
#define PG8_SA(b, h) (((b) * 2 + (h)) * HTB)
#define PG8_SB(b, h) ((4 + (b) * 2 + (h)) * HTB)
#define PG8_STAGE(bufoff, gbase, voff) do { _Pragma("unroll") for (int _i = 0; _i < 2; ++_i) \
        __builtin_amdgcn_global_load_lds((const unsigned*)((const char*)(gbase) + (voff)[_i]), (PG8_LAS unsigned*)(lds + (bufoff) + ldsw + _i * 8192), 16, 0, 0); } while (0)
#define PG8_LDA(dst, b, h) do { _Pragma("unroll") for (int m = 0; m < 4; ++m) _Pragma("unroll") for (int k = 0; k < 2; ++k) dst[m][k] = *(const PG8_LAS bf16x8*)(lds + PG8_SA(b, h) + aoff + m * 2048 + k * 1024); } while (0)
#define PG8_LDB(dst, b, h) do { _Pragma("unroll") for (int n = 0; n < 2; ++n) _Pragma("unroll") for (int k = 0; k < 2; ++k) dst[n][k] = *(const PG8_LAS bf16x8*)(lds + PG8_SB(b, h) + boff + n * 2048 + k * 1024); } while (0)
#define PG8_MMA(ai, bj, At, Bt) do { __builtin_amdgcn_s_setprio(1); _Pragma("unroll") for (int m = 0; m < 4; ++m) _Pragma("unroll") for (int n = 0; n < 2; ++n) _Pragma("unroll") for (int k = 0; k < 2; ++k) \
        acc[ai][bj][m][n] = __builtin_amdgcn_mfma_f32_16x16x32_bf16(Bt[n][k], At[m][k], acc[ai][bj][m][n], 0, 0, 0); __builtin_amdgcn_s_setprio(0); } while (0)
#define PG8_WAIT_V(n) asm volatile("s_waitcnt vmcnt(" #n ")" ::: "memory")
#define PG8_WAIT_L(n) asm volatile("s_waitcnt lgkmcnt(" #n ")" ::: "memory")
#define PG8_BAR __builtin_amdgcn_s_barrier()
#define PG8_SCHED __builtin_amdgcn_sched_barrier(0)
    Unit cur, nxt; int ui = 0;
    if (!S.next(0, cur)) return;
    f32x4 acc[2][2][4][2];
#pragma unroll
    for (int a = 0; a < 2; ++a)
#pragma unroll
        for (int b = 0; b < 2; ++b)
#pragma unroll
            for (int m = 0; m < 4; ++m)
#pragma unroll
                for (int n = 0; n < 2; ++n) acc[a][b][m][n] = (f32x4){0.f, 0.f, 0.f, 0.f};
    bf16x8 At[4][2], B0[2][2], B1[2][2];
    const char* cA = (const char*)g.A + (size_t)cur.pm * tstep; const char* cB = (const char*)g.Bt + (size_t)cur.pn * tstep;
    S.a_ready(cur);
    if constexpr (SP2) {
        PG8_STAGE(PG8_SB(0, 0), cB, voffB); PG8_STAGE(PG8_SB(0, 1), cB + hstep, voffB); PG8_STAGE(PG8_SA(0, 0), cA, voffA); PG8_STAGE(PG8_SA(0, 1), cA + hstep, voffA);
        if (wr == 1) PG8_BAR;
        PG8_WAIT_V(2); PG8_BAR;
        PG8_STAGE(PG8_SB(1, 0), cB + kstep, voffB); PG8_STAGE(PG8_SA(1, 0), cA + kstep, voffA); PG8_STAGE(PG8_SB(1, 1), cB + hstep + kstep, voffB);
        PG8_WAIT_V(6); PG8_BAR;
    } else {
        PG8_STAGE(PG8_SB(0, 0), cB, voffB); PG8_STAGE(PG8_SA(0, 0), cA, voffA); PG8_STAGE(PG8_SB(0, 1), cB + hstep, voffB); PG8_STAGE(PG8_SA(0, 1), cA + hstep, voffA);
        if (wr == 1) PG8_BAR;
        PG8_WAIT_V(4); PG8_BAR;
        PG8_STAGE(PG8_SB(1, 0), cB + kstep, voffB); PG8_STAGE(PG8_SA(1, 0), cA + kstep, voffA); PG8_STAGE(PG8_SB(1, 1), cB + hstep + kstep, voffB);
        PG8_WAIT_V(6); PG8_BAR;
    }
    for (;;) {
        const bool has_next = S.next(ui + 1, nxt);
        const char* nA = has_next ? (const char*)g.A + (size_t)nxt.pm * tstep : cA; const char* nB = has_next ? (const char*)g.Bt + (size_t)nxt.pn * tstep : cB;
        for (int t = 0; t < nt; t += 2) {
            const bool last = (t == nt - 2);
            const char* a1 = cA + (size_t)(t + 1) * kstep;
            const char* a2 = last ? nA : cA + (size_t)(t + 2) * kstep; const char* b2 = last ? nB : cB + (size_t)(t + 2) * kstep;
            const char* a3 = a2 + kstep; const char* b3 = b2 + kstep;
            if (last && has_next) S.a_ready(nxt);
            if constexpr (SP2) {
            PG8_LDB(B0, 0, 0); PG8_LDB(B1, 0, 1); PG8_SCHED; PG8_LDA(At, 0, 0); PG8_STAGE(PG8_SA(1, 1), a1 + hstep, voffA);
            PG8_WAIT_V(8); PG8_WAIT_L(0); PG8_BAR; PG8_MMA(0, 0, At, B0); PG8_MMA(0, 1, At, B1); PG8_BAR; PG8_SCHED;
            PG8_LDA(At, 0, 1); PG8_STAGE(PG8_SB(0, 0), b2, voffB); PG8_STAGE(PG8_SB(0, 1), b2 + hstep, voffB); PG8_STAGE(PG8_SA(0, 0), a2, voffA);
            PG8_WAIT_V(8); PG8_WAIT_L(0); PG8_BAR; PG8_MMA(1, 0, At, B0); PG8_MMA(1, 1, At, B1); PG8_BAR; PG8_SCHED;
            PG8_LDB(B0, 1, 0); PG8_LDB(B1, 1, 1); PG8_SCHED; PG8_LDA(At, 1, 0); PG8_STAGE(PG8_SA(0, 1), a2 + hstep, voffA);
            PG8_WAIT_V(8); PG8_WAIT_L(0); PG8_BAR; PG8_MMA(0, 0, At, B0); PG8_MMA(0, 1, At, B1); PG8_BAR; PG8_SCHED;
            PG8_LDA(At, 1, 1); PG8_STAGE(PG8_SB(1, 0), b3, voffB); PG8_STAGE(PG8_SB(1, 1), b3 + hstep, voffB); PG8_STAGE(PG8_SA(1, 0), a3, voffA);
            PG8_WAIT_V(8); PG8_WAIT_L(0); PG8_BAR; PG8_MMA(1, 0, At, B0); PG8_MMA(1, 1, At, B1); PG8_BAR; PG8_SCHED;
            } else {
            PG8_LDB(B0, 0, 0); PG8_SCHED; PG8_LDA(At, 0, 0); PG8_STAGE(PG8_SA(1, 1), a1 + hstep, voffA);
            PG8_WAIT_L(8); PG8_BAR; PG8_WAIT_L(0); PG8_MMA(0, 0, At, B0); PG8_BAR; PG8_SCHED;
            PG8_LDB(B1, 0, 1); PG8_STAGE(PG8_SB(0, 0), b2, voffB);
            PG8_BAR; PG8_WAIT_L(0); PG8_MMA(0, 1, At, B1); PG8_BAR;
            PG8_LDA(At, 0, 1); PG8_STAGE(PG8_SA(0, 0), a2, voffA);
            PG8_BAR; PG8_WAIT_L(0); PG8_MMA(1, 0, At, B0); PG8_BAR; PG8_SCHED;
            PG8_STAGE(PG8_SB(0, 1), b2 + hstep, voffB);
            PG8_WAIT_V(6); PG8_BAR; PG8_MMA(1, 1, At, B1); PG8_BAR;
            PG8_LDB(B0, 1, 0); PG8_SCHED; PG8_LDA(At, 1, 0); PG8_STAGE(PG8_SA(0, 1), a2 + hstep, voffA);
            PG8_WAIT_L(8); PG8_BAR; PG8_WAIT_L(0); PG8_MMA(0, 0, At, B0); PG8_BAR; PG8_SCHED;
            PG8_LDB(B1, 1, 1); PG8_STAGE(PG8_SB(1, 0), b3, voffB);
            PG8_BAR; PG8_WAIT_L(0); PG8_MMA(0, 1, At, B1); PG8_BAR;
            PG8_LDA(At, 1, 1); PG8_STAGE(PG8_SA(1, 0), a3, voffA);
            PG8_BAR; PG8_WAIT_L(0); PG8_MMA(1, 0, At, B0); PG8_BAR; PG8_SCHED;
            PG8_STAGE(PG8_SB(1, 1), b3 + hstep, voffB);
            PG8_WAIT_V(6); PG8_BAR; PG8_MMA(1, 1, At, B1); PG8_BAR;
            }
        }
        if constexpr (ALIGN_EPI) { if (wr == 0) PG8_BAR; }
        if constexpr (!Epi::AFTER_DRAIN) { E(acc, cur, wr, wc, fr, fq); S.done(cur); }
        if (!has_next) break;
#pragma unroll
        for (int a = 0; a < 2; ++a)
#pragma unroll
            for (int b = 0; b < 2; ++b)
#pragma unroll
                for (int m = 0; m < 4; ++m)
#pragma unroll
                    for (int n = 0; n < 2; ++n) acc[a][b][m][n] = (f32x4){0.f, 0.f, 0.f, 0.f};
        cur = nxt; cA = nA; cB = nB; ++ui;
        if constexpr (ALIGN_EPI) { if (wr == 1) PG8_BAR; }
    }
    PG8_WAIT_V(0);
    if constexpr (!ALIGN_EPI) { if (wr == 0) PG8_BAR; }
    PG8_BAR;
    if constexpr (Epi::AFTER_DRAIN) { E.fused(acc, cur, wr, wc, fr, fq, lds, wid, lane); S.done(cur); }
#undef PG8_SA
#undef PG8_SB
#undef PG8_STAGE
#undef PG8_LDA
#undef PG8_LDB
#undef PG8_MMA
#undef PG8_WAIT_V
#undef PG8_WAIT_L
#undef PG8_BAR
#undef PG8_SCHED
}
}

#define LAS __attribute__((address_space(3)))
#define DI __device__ __forceinline__
typedef unsigned short bf16;
typedef short bf16x8 __attribute__((ext_vector_type(8)));
typedef short s16x4 __attribute__((ext_vector_type(4)));
typedef float f32x4 __attribute__((ext_vector_type(4)));
typedef float f32x16 __attribute__((ext_vector_type(16)));
typedef unsigned u32x4 __attribute__((ext_vector_type(4)));
typedef unsigned u32x2 __attribute__((ext_vector_type(2)));
#define MFMA32(a, b, c) __builtin_amdgcn_mfma_f32_32x32x16_bf16((a), (b), (c), 0, 0, 0)
using pg8::pk2; using pg8::f2bf1;
DI float bf2f(unsigned v) { return __uint_as_float(v << 16); }
DI int crow(int i, int h) { return (i & 3) + 8 * (i >> 2) + 4 * h; }

__device__ const float INV_FREQ[32] = {1.000000000e+00f, 7.498942614e-01f, 5.623413324e-01f, 4.216965139e-01f, 3.162277639e-01f, 2.371373773e-01f, 1.778279394e-01f, 1.333521307e-01f,
    1.000000015e-01f, 7.498941571e-02f, 5.623413250e-02f, 4.216965288e-02f, 3.162277490e-02f, 2.371373773e-02f, 1.778279431e-02f, 1.333521493e-02f,
    9.999999776e-03f, 7.498941850e-03f, 5.623413250e-03f, 4.216964822e-03f, 3.162277630e-03f, 2.371373586e-03f, 1.778279431e-03f, 1.333521446e-03f,
    1.000000047e-03f, 7.498942432e-04f, 5.623413017e-04f, 4.216965172e-04f, 3.162277571e-04f, 2.371373703e-04f, 1.778279402e-04f, 1.333521504e-04f};

struct Args { const void* in[23]; float* out; unsigned char* ws; int ph_lo, ph_hi; };

DI int opaque_tid() { int t = threadIdx.x; asm volatile("" : "+v"(t)); return t; }
DI int opaque_bid() { int b = blockIdx.x; asm volatile("" : "+s"(b)); return b; }
DI float wave_sum(float v) {
#pragma unroll
    for (int o = 1; o < 64; o <<= 1) v += __shfl_xor(v, o);
    return v;
}

DI int rowmap(int mode, int n) {
    if (mode == 1) {
        if (n < 256) return n;
        if (n < 512) { const int q = n - 256, g = q >> 6, dd = q & 63; return 256 + 128 * (dd >> 5) + 32 * g + (dd & 31); }
        if (n < 768) return n;
        if (n < 1408) { const int base = n & ~63, d = n & 63; return base + 8 * ((d & 31) >> 2) + 4 * (d >> 5) + (d & 3); }
        return n;
    }
    if (mode == 2) {
        if (n < D_FF) return 8 * (n >> 2) + (n & 3);
        const int q = n - D_FF; return 8 * (q >> 2) + 4 + (q & 3);
    }
    return n;
}
DI void transpose_item(const float* W, int K, int N, bf16* WT, int mode, const float* gain, LAS float* scr, int item, int lane) {
    const int nblk = N / 32, kb = item / nblk, nbk = item % nblk, k0 = 64 * kb, n0 = 32 * nbk;
#pragma unroll 8
    for (int i = 0; i < 32; ++i) { const int kk = 2 * i + (lane >> 5); float v = W[(size_t)(k0 + kk) * N + n0 + (lane & 31)]; if (gain) v *= gain[k0 + kk]; scr[kk * 33 + (lane & 31)] = v; }
    asm volatile("s_waitcnt lgkmcnt(0)" ::: "memory"); __builtin_amdgcn_wave_barrier();
    const int c = lane & 7;
#pragma unroll
    for (int j = 0; j < 4; ++j) { const int n = (lane >> 3) + 8 * j; const LAS float* s = scr + (8 * c) * 33 + n;
        u32x4 o; o.x = pk2(s[0 * 33], s[1 * 33]); o.y = pk2(s[2 * 33], s[3 * 33]); o.z = pk2(s[4 * 33], s[5 * 33]); o.w = pk2(s[6 * 33], s[7 * 33]);
        *(u32x4*)(WT + (size_t)rowmap(mode, n0 + n) * K + k0 + 8 * c) = o; }
    asm volatile("s_waitcnt lgkmcnt(0)" ::: "memory"); __builtin_amdgcn_wave_barrier();
}

DI void prologue(const Args& a, LAS unsigned char* lds, int G) {
    unsigned char* ws = a.ws;
    const int tid = threadIdx.x, lane = tid & 63, wave = tid >> 6;
    const int gw = blockIdx.x * NWAVES + wave, NGW = G * NWAVES;
    const int gt = blockIdx.x * NTHREADS + tid, NGT = G * NTHREADS;
    LAS float* scr = (LAS float*)(lds + wave * 16384);
    constexpr int I_IN = 16 * 48, I_O = 16 * 32, I_GU = 16 * 176, I_DN = 44 * 32, I_KV = 16 * 64;
    constexpr int PER_L = I_IN + 3 * I_O + I_GU + I_DN + I_KV;
    for (int it = gw; it < DEPTH * PER_L; it += NGW) {
        const int l = it / PER_L; int r = it % PER_L;
        if (r < I_IN) { transpose_item(((const float*)a.in[6]) + (size_t)l * DM * D_IN, DM, D_IN, (bf16*)(ws + WS_WIN) + (size_t)l * D_IN * DM, 1, ((const float*)a.in[4]) + l * DM, scr, r, lane); continue; } r -= I_IN;
        if (r < I_O) { transpose_item(((const float*)a.in[13]) + (size_t)l * DM * DM, DM, DM, (bf16*)(ws + WS_WO) + (size_t)l * DM * DM, 0, nullptr, scr, r, lane); continue; } r -= I_O;
        if (r < I_O) { transpose_item(((const float*)a.in[16]) + (size_t)l * DM * DM, DM, DM, (bf16*)(ws + WS_WXQ) + (size_t)l * DM * DM, 0, ((const float*)a.in[14]) + l * DM, scr, r, lane); continue; } r -= I_O;
        if (r < I_O) { transpose_item(((const float*)a.in[18]) + (size_t)l * DM * DM, DM, DM, (bf16*)(ws + WS_WXO) + (size_t)l * DM * DM, 0, nullptr, scr, r, lane); continue; } r -= I_O;
        if (r < I_GU) { transpose_item(((const float*)a.in[21]) + (size_t)l * DM * 2 * D_FF, DM, 2 * D_FF, (bf16*)(ws + WS_WGU) + (size_t)l * 2 * D_FF * DM, 2, ((const float*)a.in[19]) + l * DM, scr, r, lane); continue; } r -= I_GU;
        if (r < I_DN) { transpose_item(((const float*)a.in[22]) + (size_t)l * D_FF * DM, D_FF, DM, (bf16*)(ws + WS_WDN) + (size_t)l * DM * D_FF, 0, nullptr, scr, r, lane); continue; } r -= I_DN;
        transpose_item(((const float*)a.in[17]) + (size_t)l * DM * 2 * DM, DM, 2 * DM, (bf16*)(ws + WS_WXKV) + (size_t)l * 2 * DM * DM, 0, nullptr, scr, r, lane);
    }
    { bf16* WMk = (bf16*)(ws + WS_WM);
      for (int i = gt; i < DEPTH * 4 * 128 * 128; i += NGT) { const int s = i & 127, t = (i >> 7) & 127; WMk[i] = (s <= t) ? f2bf1(((const float*)a.in[8])[i]) : (bf16)0; }
      bf16* PWT = (bf16*)(ws + WS_PWT);
      for (int i = gt; i < DEPTH * 4 * 64 * 64; i += NGT) { const int c = i & 63, d = (i >> 6) & 63, lg = i >> 12; PWT[i] = f2bf1(((const float*)a.in[10])[(size_t)lg * 4096 + c * 64 + d]); }
      float* par = (float*)(ws + WS_PAR);
      for (int i = gt; i < 1024; i += NGT) par[PAR_VG + i] = ((const float*)a.in[7])[i];
      for (int i = gt; i < 2048; i += NGT) par[PAR_BS + i] = ((const float*)a.in[9])[i];
      for (int i = gt; i < 1024; i += NGT) par[PAR_PSC + i] = ((const float*)a.in[11])[i];
      for (int i = gt; i < 32; i += NGT) par[PAR_SNK + i] = ((const float*)a.in[12])[i];
      for (int i = gt; i < DEPTH * 3 * DM; i += NGT) { const int l = i / (3 * DM), k = (i / DM) % 3, c = i % DM; par[PAR_GPOST + i] = ((const float*)a.in[k == 0 ? 5 : (k == 1 ? 15 : 20)])[l * DM + c]; }
      float* cosT = (float*)(ws + WS_COS); float* sinT = (float*)(ws + WS_SIN);
      for (int i = gt; i < M * 32; i += NGT) {
          const int r = i >> 5, k = i & 31;
          const float ang = (float)((const int*)a.in[2])[r] * INV_FREQ[k];
          const double ad = (double)ang;
          const double q = __builtin_rint(ad * 0.63661977236758134308);
          double rr = __builtin_fma(-q, 1.57079632679489655800e+00, ad); rr = __builtin_fma(-q, 6.12323399573676603587e-17, rr);
          const double x2 = rr * rr;
          double sp = -1.0 / 6227020800.0; sp = sp * x2 + 1.0 / 39916800.0; sp = sp * x2 - 1.0 / 362880.0; sp = sp * x2 + 1.0 / 5040.0; sp = sp * x2 - 1.0 / 120.0; sp = sp * x2 + 1.0 / 6.0; sp = rr - rr * x2 * sp;
          double cp = 1.0 / 87178291200.0; cp = cp * x2 - 1.0 / 479001600.0; cp = cp * x2 + 1.0 / 3628800.0; cp = cp * x2 - 1.0 / 40320.0; cp = cp * x2 + 1.0 / 720.0; cp = cp * x2 - 1.0 / 24.0; cp = cp * x2 + 0.5; cp = 1.0 - x2 * cp;
          const int qi = ((int)q) & 3;
          const double sv = (qi == 0) ? sp : (qi == 1) ? cp : (qi == 2) ? -sp : -cp;
          const double cv = (qi == 0) ? cp : (qi == 1) ? -sp : (qi == 2) ? -cp : sp;
          cosT[i] = (float)cv; sinT[i] = (float)sv;
      }
    }
    { bf16* XB = (bf16*)(ws + WS_XB); float* rsx = (float*)(ws + WS_RS);
      for (int r = gw; r < M; r += NGW) {
          const f32x4* xr = (const f32x4*)(((const float*)a.in[0]) + (size_t)r * DM) + lane; float ss = 0.f;
#pragma unroll
          for (int j = 0; j < 4; ++j) { const f32x4 v = xr[64 * j]; ss += (v[0] * v[0] + v[1] * v[1]) + (v[2] * v[2] + v[3] * v[3]);
              u32x2 w; w.x = pk2(v[0], v[1]); w.y = pk2(v[2], v[3]); *((u32x2*)(XB + (size_t)r * DM) + lane + 64 * j) = w; }
          ss = wave_sum(ss); if (lane == 0) rsx[r] = rsqrtf(ss * (1.f / DM) + EPS);
      }
      bf16* MN = (bf16*)(ws + WS_MEMN);
      for (int r = gw; r < MMEM; r += NGW) {
          const f32x4* xr = (const f32x4*)(((const float*)a.in[1]) + (size_t)r * DM) + lane; f32x4 v[4]; float ss = 0.f;
#pragma unroll
          for (int j = 0; j < 4; ++j) { v[j] = xr[64 * j]; ss += (v[j][0] * v[j][0] + v[j][1] * v[j][1]) + (v[j][2] * v[j][2] + v[j][3] * v[j][3]); }
          ss = wave_sum(ss); const float rn = rsqrtf(ss * (1.f / DM) + EPS);
#pragma unroll
          for (int j = 0; j < 4; ++j) { const f32x4 g = *((const f32x4*)((const float*)a.in[3]) + lane + 64 * j); const f32x4 o = v[j] * rn * g;
              u32x2 w; w.x = pk2(o[0], o[1]); w.y = pk2(o[2], o[3]); *((u32x2*)(MN + (size_t)r * DM) + lane + 64 * j) = w; }
      }
    }
}

DI void res_phase(float* out_final, unsigned char* ws, int gidx, int G) {
    const bf16* Y = (const bf16*)(ws + WS_Y); const float* ysq = (const float*)(ws + WS_YSQ); const float* gpost = (const float*)(ws + WS_PAR) + PAR_GPOST + gidx * DM; bf16* XB = (bf16*)(ws + WS_XB); float* rsx = (float*)(ws + WS_RS);
    const int tid = opaque_tid(), lane = tid & 63, wave = tid >> 6;
    const int gw = opaque_bid() * NWAVES + wave, NGW = G * NWAVES;
    f32x4 g4[4];
#pragma unroll
    for (int j = 0; j < 4; ++j) g4[j] = *((const f32x4*)gpost + lane + 64 * j);
    for (int r = gw; r < M; r += NGW) {
        float ysum = 0.f;
#pragma unroll
        for (int j = 0; j < 4; ++j) { const f32x4 q = *((const f32x4*)(ysq + (size_t)r * 16) + j); ysum += (q[0] + q[1]) + (q[2] + q[3]); }
        const float rn = rsqrtf(ysum * (1.f / DM) + EPS);
        float ss = 0.f;
#pragma unroll
        for (int j = 0; j < 4; ++j) {
            const u32x2 xw = *((const u32x2*)(XB + (size_t)r * DM) + lane + 64 * j);
            const u32x2 yw = *((const u32x2*)(Y + (size_t)r * DM) + lane + 64 * j);
            f32x4 xv; xv[0] = bf2f(xw.x & 0xffffu); xv[1] = bf2f(xw.x >> 16); xv[2] = bf2f(xw.y & 0xffffu); xv[3] = bf2f(xw.y >> 16);
            f32x4 yv; yv[0] = bf2f(yw.x & 0xffffu); yv[1] = bf2f(yw.x >> 16); yv[2] = bf2f(yw.y & 0xffffu); yv[3] = bf2f(yw.y >> 16);
            const f32x4 xn = xv + yv * rn * g4[j];
            if (out_final) *((f32x4*)(out_final + (size_t)r * DM) + lane + 64 * j) = xn;
            else { ss += (xn[0] * xn[0] + xn[1] * xn[1]) + (xn[2] * xn[2] + xn[3] * xn[3]);
                u32x2 w; w.x = pk2(xn[0], xn[1]); w.y = pk2(xn[2], xn[3]); *((u32x2*)(XB + (size_t)r * DM) + lane + 64 * j) = w; }
        }
        if (!out_final) { ss = wave_sum(ss); if (lane == 0) rsx[r] = rsqrtf(ss * (1.f / DM) + EPS); }
    }
}

template <int G_> DI void pool_group(const LAS unsigned char* Pt, const bf16* PWT, const float* pscale, bf16* MIX, int row0, int nb, int tt, int dtile, int c32, int h) {
    constexpr int w = 2 << G_;
    f32x16 acc;
#pragma unroll
    for (int i = 0; i < 16; ++i) acc[i] = 0.f;
    const int t = 32 * tt + c32, tpos = nb * 128 + t; const int cnt = (tpos + 1 < w) ? (tpos + 1) : w; const float icnt = 1.f / (float)cnt;
#pragma unroll
    for (int ks = 0; ks < 4; ++ks) {
        const LAS unsigned char* prow = Pt + (16 + t) * 528 + (G_ * 64 + 16 * ks + 8 * h) * 2;
        float sum[8], own[8];
#pragma unroll 4
        for (int k = 0; k < w; ++k) { const u32x4 v = *(const LAS u32x4*)(prow - k * 528);
            float f[8]; f[0] = bf2f(v.x & 0xffffu); f[1] = bf2f(v.x >> 16); f[2] = bf2f(v.y & 0xffffu); f[3] = bf2f(v.y >> 16); f[4] = bf2f(v.z & 0xffffu); f[5] = bf2f(v.z >> 16); f[6] = bf2f(v.w & 0xffffu); f[7] = bf2f(v.w >> 16);
#pragma unroll
            for (int e = 0; e < 8; ++e) { if (k == 0) { own[e] = f[e]; sum[e] = f[e]; } else sum[e] += f[e]; } }
        u32x4 pa; pa.x = pk2(sum[0] * icnt - own[0], sum[1] * icnt - own[1]); pa.y = pk2(sum[2] * icnt - own[2], sum[3] * icnt - own[3]);
        pa.z = pk2(sum[4] * icnt - own[4], sum[5] * icnt - own[5]); pa.w = pk2(sum[6] * icnt - own[6], sum[7] * icnt - own[7]);
        const bf16x8 bfr = *(const bf16x8*)(PWT + ((unsigned)(G_ * 64 + 32 * dtile + c32)) * 64 + 16 * ks + 8 * h);
        acc = MFMA32(__builtin_bit_cast(bf16x8, pa), bfr, acc);
    }
    const int d = G_ * 64 + 32 * dtile + c32; const float psc = pscale[d];
#pragma unroll
    for (int i = 0; i < 16; ++i) { const unsigned r = (unsigned)(row0 + 32 * tt + crow(i, h)); MIX[r * 1024 + 256 + d] = f2bf1(acc[i] * psc); }
}

DI void mixer_phase(unsigned char* ws, int l, LAS unsigned char* lds, int G) {
    const bf16* U = (const bf16*)(ws + WS_U); const bf16* VNT = (const bf16*)(ws + WS_VNT); const bf16* P = (const bf16*)(ws + WS_P);
    const bf16* Q = (const bf16*)(ws + WS_Q); const bf16* Kb = (const bf16*)(ws + WS_K); const bf16* VT = (const bf16*)(ws + WS_VT);
    bf16* MIX = (bf16*)(ws + WS_BUFA);
    const bf16* WMk = (const bf16*)(ws + WS_WM) + (unsigned)l * 4 * 128 * 128; const bf16* PWT = (const bf16*)(ws + WS_PWT) + (unsigned)l * 4 * 64 * 64;
    const float* par = (const float*)(ws + WS_PAR); const float* bs = par + PAR_BS + l * 512; const float* pscale = par + PAR_PSC + l * 256; const float* sinks = par + PAR_SNK + l * 8;
    const int tid0 = opaque_tid(), lane = tid0 & 63, wave = __builtin_amdgcn_readfirstlane(tid0 >> 6), c32 = lane & 31, h = lane >> 5;
    for (int blk = opaque_bid(); blk < M / 128; blk += G) {
        const int row0 = blk * 128, b = blk >> 5, nb = blk & 31;
        const int tt = wave >> 1, dtile = wave & 1;
        { u32x4 pt[9]; int tid = tid0; asm volatile("" : "+v"(tid));
#pragma unroll
          for (int it = 0; it < 9; ++it) { const int id = tid + NTHREADS * it, rr = id >> 5, ch = id & 31; pt[it] = (u32x4){0u, 0u, 0u, 0u};
              if (nb > 0 || rr >= 16) pt[it] = *(const u32x4*)(P + (unsigned)(row0 - 16 + rr) * 256 + ch * 8); }
#pragma unroll
          for (int it = 0; it < 9; ++it) { const int id = tid + NTHREADS * it, rr = id >> 5, ch = id & 31; *(LAS u32x4*)(lds + rr * 528 + ch * 16) = pt[it]; } }
#pragma unroll 1
        for (int g = 0; g < 4; ++g) {
            f32x16 acc;
#pragma unroll
            for (int i = 0; i < 16; ++i) acc[i] = 0.f;
            const bf16* Wrow = WMk + ((unsigned)(g * 128 + 32 * tt + c32)) * 128 + 8 * h;
            const bf16* Vrow = VNT + ((unsigned)(blk * 4 + g) * 64 + 32 * dtile + c32) * 128 + 8 * h;
            const int d = g * 64 + 32 * dtile + c32;
            float uu[16];
#pragma unroll
            for (int i = 0; i < 16; ++i) { const int t = 32 * tt + crow(i, h); uu[i] = bf2f(U[(unsigned)(row0 + t) * 256 + d]); }
#pragma unroll
            for (int kb = 0; kb < 2; ++kb) { bf16x8 af[4], bfr[4];
#pragma unroll
                for (int ks = 0; ks < 4; ++ks) { af[ks] = *(const bf16x8*)(Wrow + 16 * (4 * kb + ks)); bfr[ks] = *(const bf16x8*)(Vrow + 16 * (4 * kb + ks)); }
#pragma unroll
                for (int ks = 0; ks < 4; ++ks) acc = MFMA32(af[ks], bfr[ks], acc); }
            float bb[16];
#pragma unroll
            for (int i = 0; i < 16; ++i) bb[i] = bs[g * 128 + 32 * tt + crow(i, h)];
#pragma unroll
            for (int i = 0; i < 16; ++i) { const unsigned r = (unsigned)(row0 + 32 * tt + crow(i, h)); MIX[r * 1024 + d] = f2bf1(uu[i] * (acc[i] + bb[i])); }
        }
        __syncthreads();
        pool_group<0>(lds, PWT, pscale, MIX, row0, nb, tt, dtile, c32, h);
        pool_group<1>(lds, PWT, pscale, MIX, row0, nb, tt, dtile, c32, h);
        pool_group<2>(lds, PWT, pscale, MIX, row0, nb, tt, dtile, c32, h);
        pool_group<3>(lds, PWT, pscale, MIX, row0, nb, tt, dtile, c32, h);
        __syncthreads();
        { u32x4 kreg[8], vreg[8]; int tid = tid0; asm volatile("" : "+v"(tid));
#pragma unroll
          for (int it = 0; it < 8; ++it) { const int id = tid + NTHREADS * it;
              { const int hv = id >> 11, kk = (id >> 3) & 255, ch = id & 7; kreg[it] = (u32x4){0u, 0u, 0u, 0u};
                if (nb > 0 || kk >= 128) kreg[it] = *(const u32x4*)(Kb + (unsigned)(row0 - 128 + kk) * 128 + hv * 64 + ch * 8); }
              { const int hv = id >> 11, d = (id >> 5) & 63, ch = id & 31; vreg[it] = (u32x4){0u, 0u, 0u, 0u};
                if (nb > 0 || ch >= 16) vreg[it] = *(const u32x4*)(VT + ((unsigned)((b * 2 + hv) * 32 + nb - 1 + (ch >> 4)) * 64 + d) * 128 + (ch & 15) * 8); } }
#pragma unroll
          for (int it = 0; it < 8; ++it) { const int id = tid + NTHREADS * it;
              { const int hv = id >> 11, kk = (id >> 3) & 255, ch = id & 7; *(LAS u32x4*)(lds + hv * 36864 + kk * 144 + ch * 16) = kreg[it]; }
              { const int hv = id >> 11, d = (id >> 5) & 63, ch = id & 31; *(LAS u32x4*)(lds + 73728 + hv * 33792 + d * 528 + ch * 16) = vreg[it]; } } }
        __syncthreads();
#pragma unroll 1
        for (int tk = 0; tk < 4; ++tk) {
            const int hv = tk >> 1, it = tk & 1;
            const LAS unsigned char* Ks = lds + hv * 36864; const LAS unsigned char* Vs = lds + 73728 + hv * 33792;
            {
                const int qh = wave & 3, sb = (wave >> 2) + 2 * it, head = 4 * hv + qh;
                const unsigned r = (unsigned)(row0 + 32 * sb + c32);
                bf16x8 qf[4];
#pragma unroll
                for (int st = 0; st < 4; ++st) qf[st] = *(const bf16x8*)(Q + r * 512 + head * 64 + 16 * st + 8 * h);
                f32x16 S[5];
#pragma unroll
                for (int kt = 0; kt < 5; ++kt) {
#pragma unroll
                    for (int i = 0; i < 16; ++i) S[kt][i] = 0.f;
#pragma unroll
                    for (int st = 0; st < 4; ++st) { const bf16x8 kf = *(const LAS bf16x8*)(Ks + (32 * (sb + kt) + c32) * 144 + (16 * st + 8 * h) * 2); S[kt] = MFMA32(kf, qf[st], S[kt]); }
                }
                const float sink = sinks[head] * LOG2E;
                float mx = sink;
#pragma unroll
                for (int kt = 0; kt < 5; ++kt)
#pragma unroll
                    for (int i = 0; i < 16; ++i) { const int krel = 32 * kt + crow(i, h);
                        const bool valid = (krel > c32) && (krel <= c32 + 128) && (nb > 0 || 32 * sb + krel >= 128);
                        const float sv = valid ? S[kt][i] : -INFINITY; S[kt][i] = sv; mx = fmaxf(mx, sv); }
                mx = fmaxf(mx, __shfl_xor(mx, 32));
                float sum = 0.f;
#pragma unroll
                for (int kt = 0; kt < 5; ++kt)
#pragma unroll
                    for (int i = 0; i < 16; ++i) { const float e = __builtin_amdgcn_exp2f(S[kt][i] - mx); S[kt][i] = e; sum += e; }
                sum += __shfl_xor(sum, 32); sum += __builtin_amdgcn_exp2f(sink - mx);
                const float inv = 1.f / sum;
                f32x16 O[2];
#pragma unroll
                for (int i = 0; i < 16; ++i) { O[0][i] = 0.f; O[1][i] = 0.f; }
#pragma unroll
                for (int kt = 0; kt < 5; ++kt)
#pragma unroll
                    for (int s = 0; s < 2; ++s) {
                        u32x4 pw; pw.x = pk2(S[kt][8 * s + 0], S[kt][8 * s + 1]); pw.y = pk2(S[kt][8 * s + 2], S[kt][8 * s + 3]); pw.z = pk2(S[kt][8 * s + 4], S[kt][8 * s + 5]); pw.w = pk2(S[kt][8 * s + 6], S[kt][8 * s + 7]);
                        const bf16x8 pf = __builtin_bit_cast(bf16x8, pw);
#pragma unroll
                        for (int dt = 0; dt < 2; ++dt) { const LAS unsigned char* vp = Vs + (32 * dt + c32) * 528 + (32 * (sb + kt) + 16 * s + 4 * h) * 2;
                            const u32x2 lo = *(const LAS u32x2*)vp, hi = *(const LAS u32x2*)(vp + 16);
                            u32x4 vv; vv.x = lo.x; vv.y = lo.y; vv.z = hi.x; vv.w = hi.y;
                            O[dt] = MFMA32(__builtin_bit_cast(bf16x8, vv), pf, O[dt]); }
                    }
#pragma unroll
                for (int dt = 0; dt < 2; ++dt)
#pragma unroll
                    for (int g4 = 0; g4 < 4; ++g4) { u32x2 w; w.x = pk2(O[dt][4 * g4] * inv, O[dt][4 * g4 + 1] * inv); w.y = pk2(O[dt][4 * g4 + 2] * inv, O[dt][4 * g4 + 3] * inv);
                        *(u32x2*)(MIX + r * 1024 + 512 + head * 64 + 32 * dt + 8 * g4 + 4 * h) = w; }
            }
        }
        __syncthreads();
    }
}

DI void xattn_phase(unsigned char* ws, int l, LAS unsigned char* lds, int G) {
    const bf16* QX = (const bf16*)(ws + WS_BUFA); bf16* OX = (bf16*)(ws + WS_U);
    const bf16* KM = (const bf16*)(ws + WS_KM) + (size_t)l * MMEM * DM; const bf16* VTM = (const bf16*)(ws + WS_VTM) + (size_t)l * MMEM * DM;
    const int tid = opaque_tid(), lane = tid & 63, wave = __builtin_amdgcn_readfirstlane(tid >> 6), c32 = lane & 31, h = lane >> 5;
    for (int item = opaque_bid(); item < NBATCH * 4 * 16; item += G) {
        const int qc = item & 15, head = (item >> 4) & 3, b = item >> 6;
        __syncthreads();
#pragma unroll 4
        for (int it = 0; it < 16; ++it) { const int id = tid + NTHREADS * it, mrow = id >> 5, ch = id & 31;
            *(LAS u32x4*)(lds + mrow * 528 + ch * 16) = *(const u32x4*)(KM + (size_t)(b * 256 + mrow) * 1024 + head * 256 + ch * 8); }
        __syncthreads();
        const size_t r = (size_t)b * SEQ + qc * 256 + 32 * wave + c32;
        f32x16 S[8];
#pragma unroll
        for (int mt = 0; mt < 8; ++mt)
#pragma unroll
            for (int i = 0; i < 16; ++i) S[mt][i] = 0.f;
#pragma unroll 2
        for (int st = 0; st < 16; ++st) { const bf16x8 qf = *(const bf16x8*)(QX + r * 1024 + head * 256 + 16 * st + 8 * h);
#pragma unroll
            for (int mt = 0; mt < 8; ++mt) { const bf16x8 kf = *(const LAS bf16x8*)(lds + (32 * mt + c32) * 528 + (16 * st + 8 * h) * 2); S[mt] = MFMA32(kf, qf, S[mt]); } }
        float mx = -INFINITY;
#pragma unroll
        for (int mt = 0; mt < 8; ++mt)
#pragma unroll
            for (int i = 0; i < 16; ++i) mx = fmaxf(mx, S[mt][i]);
        mx = fmaxf(mx, __shfl_xor(mx, 32));
        float sum = 0.f; bf16x8 pf[8][2];
#pragma unroll
        for (int mt = 0; mt < 8; ++mt) {
#pragma unroll
            for (int i = 0; i < 16; ++i) { const float e = __builtin_amdgcn_exp2f(S[mt][i] - mx); S[mt][i] = e; sum += e; }
#pragma unroll
            for (int s = 0; s < 2; ++s) { u32x4 pw; pw.x = pk2(S[mt][8 * s + 0], S[mt][8 * s + 1]); pw.y = pk2(S[mt][8 * s + 2], S[mt][8 * s + 3]); pw.z = pk2(S[mt][8 * s + 4], S[mt][8 * s + 5]); pw.w = pk2(S[mt][8 * s + 6], S[mt][8 * s + 7]);
                pf[mt][s] = __builtin_bit_cast(bf16x8, pw); }
        }
        sum += __shfl_xor(sum, 32);
        const float inv = 1.f / sum;
        __syncthreads();
#pragma unroll 4
        for (int it = 0; it < 16; ++it) { const int id = tid + NTHREADS * it, d = id >> 5, ch = id & 31;
            *(LAS u32x4*)(lds + d * 528 + ch * 16) = *(const u32x4*)(VTM + ((size_t)(b * 4 + head) * 256 + d) * 256 + ch * 8); }
        __syncthreads();
#pragma unroll 1
        for (int dt = 0; dt < 8; ++dt) {
            f32x16 O;
#pragma unroll
            for (int i = 0; i < 16; ++i) O[i] = 0.f;
#pragma unroll
            for (int mt = 0; mt < 8; ++mt)
#pragma unroll
                for (int s = 0; s < 2; ++s) { const LAS unsigned char* vp = lds + (32 * dt + c32) * 528 + (32 * mt + 16 * s + 4 * h) * 2;
                    const u32x2 lo = *(const LAS u32x2*)vp, hi = *(const LAS u32x2*)(vp + 16);
                    u32x4 vv; vv.x = lo.x; vv.y = lo.y; vv.z = hi.x; vv.w = hi.y;
                    O = MFMA32(__builtin_bit_cast(bf16x8, vv), pf[mt][s], O); }
#pragma unroll
            for (int g4 = 0; g4 < 4; ++g4) { u32x2 w; w.x = pk2(O[4 * g4] * inv, O[4 * g4 + 1] * inv); w.y = pk2(O[4 * g4 + 2] * inv, O[4 * g4 + 3] * inv);
                *(u32x2*)(OX + r * 1024 + head * 256 + 32 * dt + 8 * g4 + 4 * h) = w; }
        }
    }
    __syncthreads();
}

#define XB_TMO      128
#define XB_XCNT(j)  (256  + 64 * (j))
#define XB_XSUB(j)  (1280 + 64 * (j))
#define XB_XGEN(j)  (2304 + 64 * (j))
#define XB_TOP      3328
#define XB_TOPGEN   3392
#define XCD_BAR_WORDS 3456
#define XB_SPIN_CAP (1u << 18)

__device__ __forceinline__ unsigned xb_ld(unsigned* p)              { return __hip_atomic_load(p, __ATOMIC_RELAXED, __HIP_MEMORY_SCOPE_AGENT); }
__device__ __forceinline__ unsigned xb_add(unsigned* p, unsigned v) { return __hip_atomic_fetch_add(p, v, __ATOMIC_RELAXED, __HIP_MEMORY_SCOPE_AGENT); }
__device__ __forceinline__ unsigned xb_xcc_id() { return (unsigned)__builtin_amdgcn_s_getreg((3 << 11) | 20) & 0xFu; }
#define XB_SPIN(cond, bar) do { unsigned _sp = 0; while (cond) { __builtin_amdgcn_s_sleep(1); \
    if ((++_sp & 255u) == 0u) { if (xb_ld(&(bar)[XB_TMO])) break; if (_sp > XB_SPIN_CAP) { atomicAdd(&(bar)[XB_TMO], 1u); break; } } } } while (0)

struct XcdBarrier {
    unsigned* bar; unsigned x;
    volatile LAS unsigned* st;
};

__device__ __forceinline__ XcdBarrier xcd_barrier_post(unsigned* bar, volatile LAS unsigned* st) {
    XcdBarrier b; b.bar = bar; b.x = xb_xcc_id(); b.st = st;
    if (threadIdx.x == 0) (void)xb_add(&bar[XB_XCNT(b.x)], 1u);
    return b;
}
__device__ __forceinline__ void xcd_barrier_complete(unsigned* bar, unsigned x, unsigned& nloc, unsigned& nx) {
    const unsigned G = gridDim.x * gridDim.y * gridDim.z;
    unsigned sum, cnt, mine, sp = 0u;
    for (;;) {
        sum = 0u; cnt = 0u; mine = 0u;
#pragma unroll
        for (unsigned j = 0; j < 16; ++j) { const unsigned c = xb_ld(&bar[XB_XCNT(j)]); sum += c; cnt += (c > 0u) ? 1u : 0u; mine = (j == x) ? c : mine; }
        if (sum == G) break;
        __builtin_amdgcn_s_sleep(1);
        if ((++sp & 255u) == 0u) { if (xb_ld(&bar[XB_TMO])) break; if (sp > XB_SPIN_CAP) { atomicAdd(&bar[XB_TMO], 1u); break; } }
    }
    nloc = mine > 0u ? mine : 1u; nx = cnt > 0u ? cnt : 1u;
}

__device__ __forceinline__ void xcd_barrier(const XcdBarrier& b) {
    asm volatile("s_waitcnt vmcnt(0)" ::: "memory");
    __syncthreads();
    if (threadIdx.x == 0) {
        unsigned* bar = b.bar;
        __builtin_amdgcn_s_waitcnt(0);
        unsigned nloc = b.st[0], nx = b.st[1];
        if (nloc == 0u) { xcd_barrier_complete(bar, b.x, nloc, nx); b.st[0] = nloc; b.st[1] = nx; }
        const unsigned old = xb_add(&bar[XB_XSUB(b.x)], 1u);
        const unsigned gen = old / nloc;
        if (old + 1u == (gen + 1u) * nloc) {
            __builtin_amdgcn_fence(__ATOMIC_RELEASE, "agent");
            asm volatile("s_waitcnt vmcnt(0)" ::: "memory");
            const unsigned og = xb_add(&bar[XB_TOP], 1u);
            const unsigned tg = og / nx;
            if (og + 1u == (tg + 1u) * nx) xb_add(&bar[XB_TOPGEN], 1u);
            else XB_SPIN(xb_ld(&bar[XB_TOPGEN]) == tg, bar);
            __builtin_amdgcn_fence(__ATOMIC_ACQUIRE, "agent");
            xb_add(&bar[XB_XGEN(b.x)], 1u);
            asm volatile("s_waitcnt vmcnt(0)" ::: "memory");
        } else {
            XB_SPIN(xb_ld(&bar[XB_XGEN(b.x)]) == gen, bar);
            __builtin_amdgcn_fence(__ATOMIC_ACQUIRE, "agent");
            asm volatile("s_waitcnt vmcnt(0)" ::: "memory");
        }
    }
    __syncthreads();
}

#ifndef PG8_SP2
#define PG8_SP2 true
#endif
#ifndef PG8_ALIGN
#define PG8_ALIGN true
#endif
constexpr int N_PHASES = 2 + 11 * DEPTH;
#ifndef MK_DUP
#define MK_DUP -1
#endif
#define DUPN(k) ((MK_DUP == (k)) ? 2 : 1)

__global__ void __launch_bounds__(NTHREADS, 2) mk_fwd(Args a) {
    extern __shared__ __attribute__((aligned(16))) unsigned char lds_raw[];
    LAS unsigned char* lds = (LAS unsigned char*)lds_raw;
    cg::grid_group grid = cg::this_grid();
    const int G = gridDim.x, lo = a.ph_lo, hi = a.ph_hi;
    unsigned char* ws = a.ws;
    volatile LAS unsigned* bst = (volatile LAS unsigned*)(lds + LDS_BYTES - 64);
    unsigned* barw = (unsigned*)(ws + WS_BAR);
    XcdBarrier bar; bar.bar = barw; bar.x = 0; bar.st = bst;
    if (hi - lo > 1) {
        if (threadIdx.x < 2) bst[threadIdx.x] = 0u;
        if (blockIdx.x == 0) for (int i = threadIdx.x; i < XCD_BAR_WORDS; i += NTHREADS) __hip_atomic_store(barw + i, 0u, __ATOMIC_RELAXED, __HIP_MEMORY_SCOPE_AGENT);
        grid.sync();
        bar = xcd_barrier_post(barw, bst);
    }
#define IN(k) (lo <= (k) && (k) < hi)
#define SEAM(k) do { if (IN((k) + 1)) xcd_barrier(bar); } while (0)
    if (IN(0)) { prologue(a, lds, G); SEAM(0); }
    if (IN(1)) {
        pg8::Gemm g{(const pg8::bf16_t*)(ws + WS_MEMN), (const pg8::bf16_t*)(ws + WS_WXKV), MMEM, DEPTH * 2 * DM, DM}; pg8::StaticOrder S; S.init(MMEM, DEPTH * 2 * DM, G, opaque_bid());
        pg8::EpiKV E{ws};
        pg8::gemm_phase<pg8::EpiKV, pg8::StaticOrder, false, PG8_SP2>(lds, g, S, E);
        SEAM(1);
    }
#pragma unroll 1
    for (int l = 0; l < DEPTH; ++l) {
        const int p0 = 2 + 11 * l;
        if (IN(p0 + 0)) {
            pg8::Gemm g{(const pg8::bf16_t*)(ws + WS_XB), (const pg8::bf16_t*)(ws + WS_WIN) + (size_t)l * D_IN * DM, M, D_IN, DM}; pg8::StaticOrder S; S.init(M, D_IN, G, opaque_bid());
            pg8::EpiIn E{ws, l};
            for (int rep_ = 0; rep_ < DUPN(0); ++rep_) pg8::gemm_phase<pg8::EpiIn, pg8::StaticOrder, PG8_ALIGN, PG8_SP2>(lds, g, S, E);
            SEAM(p0 + 0);
        }
        if (IN(p0 + 1)) { for (int rep_ = 0; rep_ < DUPN(1); ++rep_) mixer_phase(ws, l, lds, G); SEAM(p0 + 1); }
        if (IN(p0 + 2)) {
            pg8::Gemm g{(const pg8::bf16_t*)(ws + WS_BUFA), (const pg8::bf16_t*)(ws + WS_WO) + (size_t)l * DM * DM, M, DM, DM}; pg8::StaticOrder S; S.init(M, DM, G, opaque_bid());
            pg8::EpiY E{ws};
            for (int rep_ = 0; rep_ < DUPN(2); ++rep_) pg8::gemm_phase<pg8::EpiY, pg8::StaticOrder, PG8_ALIGN, PG8_SP2>(lds, g, S, E);
            SEAM(p0 + 2);
        }
        if (IN(p0 + 3)) { res_phase(nullptr, ws, l * 3 + 0, G); SEAM(p0 + 3); }
        if (IN(p0 + 4)) {
            pg8::Gemm g{(const pg8::bf16_t*)(ws + WS_XB), (const pg8::bf16_t*)(ws + WS_WXQ) + (size_t)l * DM * DM, M, DM, DM}; pg8::StaticOrder S; S.init(M, DM, G, opaque_bid());
            pg8::EpiQx E{ws};
            for (int rep_ = 0; rep_ < DUPN(4); ++rep_) pg8::gemm_phase<pg8::EpiQx, pg8::StaticOrder, PG8_ALIGN, PG8_SP2>(lds, g, S, E);
            SEAM(p0 + 4);
        }
        if (IN(p0 + 5)) { for (int rep_ = 0; rep_ < DUPN(5); ++rep_) xattn_phase(ws, l, lds, G); SEAM(p0 + 5); }
        if (IN(p0 + 6)) {
            pg8::Gemm g{(const pg8::bf16_t*)(ws + WS_U), (const pg8::bf16_t*)(ws + WS_WXO) + (size_t)l * DM * DM, M, DM, DM}; pg8::StaticOrder S; S.init(M, DM, G, opaque_bid());
            pg8::EpiY E{ws};
            for (int rep_ = 0; rep_ < DUPN(6); ++rep_) pg8::gemm_phase<pg8::EpiY, pg8::StaticOrder, PG8_ALIGN, PG8_SP2>(lds, g, S, E);
            SEAM(p0 + 6);
        }
        if (IN(p0 + 7)) { res_phase(nullptr, ws, l * 3 + 1, G); SEAM(p0 + 7); }
        if (IN(p0 + 8)) {
            pg8::Gemm g{(const pg8::bf16_t*)(ws + WS_XB), (const pg8::bf16_t*)(ws + WS_WGU) + (size_t)l * 2 * D_FF * DM, M, 2 * D_FF, DM}; pg8::StaticOrder S; S.init(M, 2 * D_FF, G, opaque_bid());
            pg8::EpiGU E{ws};
            for (int rep_ = 0; rep_ < DUPN(8); ++rep_) pg8::gemm_phase<pg8::EpiGU, pg8::StaticOrder, PG8_ALIGN, PG8_SP2>(lds, g, S, E);
            SEAM(p0 + 8);
        }
        if (IN(p0 + 9)) {
            pg8::Gemm g{(const pg8::bf16_t*)(ws + WS_F), (const pg8::bf16_t*)(ws + WS_WDN) + (size_t)l * DM * D_FF, M, DM, D_FF}; pg8::StaticOrder S; S.init(M, DM, G, opaque_bid());
            pg8::EpiY E{ws};
            for (int rep_ = 0; rep_ < DUPN(9); ++rep_) pg8::gemm_phase<pg8::EpiY, pg8::StaticOrder, PG8_ALIGN, PG8_SP2>(lds, g, S, E);
            SEAM(p0 + 9);
        }
        if (IN(p0 + 10)) { res_phase(l == DEPTH - 1 ? a.out : nullptr, ws, l * 3 + 2, G); SEAM(p0 + 10); }
    }
#undef IN
#undef SEAM
}

extern "C" void kernel_launch(void* const* d_in, const int* in_sizes, int n_in, void* d_out, int out_size, void* d_ws, size_t ws_size, hipStream_t stream) {
    static int grid = 0;
    if (grid == 0) {
        if (n_in != 23 || in_sizes[0] != M * DM || out_size != M * DM || ws_size < WS_END) { fprintf(stderr, "kernel_launch: unexpected shapes (n_in %d, in0 %d, out %d, ws %zu < %zu)\n", n_in, n_in > 0 ? in_sizes[0] : -1, out_size, ws_size, (size_t)WS_END); grid = -1; return; }
        int dev = 0, cus = 0, per_cu = 0;
        (void)hipGetDevice(&dev); (void)hipDeviceGetAttribute(&cus, hipDeviceAttributeMultiprocessorCount, dev);
        if (hipFuncSetAttribute((const void*)mk_fwd, hipFuncAttributeMaxDynamicSharedMemorySize, LDS_BYTES) != hipSuccess) fprintf(stderr, "kernel_launch: hipFuncSetAttribute failed\n");
        if (hipOccupancyMaxActiveBlocksPerMultiprocessor(&per_cu, (const void*)mk_fwd, NTHREADS, LDS_BYTES) != hipSuccess || per_cu < 1) { fprintf(stderr, "kernel_launch: occupancy query says %d; using 1 per CU\n", per_cu); per_cu = 1; }
        (void)hipGetLastError();
        grid = cus * per_cu; if (grid <= 0) grid = 256;
    }
    if (grid < 0) return;
    Args a{};
    for (int i = 0; i < 23; ++i) a.in[i] = d_in[i];
    a.out = (float*)d_out; a.ws = (unsigned char*)d_ws;
#if MK_PER_PHASE
    for (int ph = 0; ph < N_PHASES; ++ph) { a.ph_lo = ph; a.ph_hi = ph + 1; hipLaunchKernelGGL(mk_fwd, dim3(grid), dim3(NTHREADS), LDS_BYTES, stream, a); }
#else
    a.ph_lo = 0; a.ph_hi = N_PHASES;
    void* args[] = {&a};
    const hipError_t e = hipLaunchCooperativeKernel((const void*)mk_fwd, dim3(grid), dim3(NTHREADS), args, LDS_BYTES, stream);
    if (e != hipSuccess) fprintf(stderr, "kernel_launch: cooperative launch failed: %s (grid %d)\n", hipGetErrorString(e), grid);
#endif
}
```
